# Optimizing an MI355X kernel written in HIP

```python
import jax, jax.numpy as jnp
from jax import lax
import numpy as np


D_MODEL = 1024
BATCH = 2
SEQ = 8192
DEPTH = 2

N_MIXERS = 2
ATT_HEADS = 8
ATT_HEAD_DIM = D_MODEL // ATT_HEADS
MOBA_BLOCK = 256
MOBA_TOPK = 3
MOBA_QUERY_CHUNK = 32
MLSTM_HEADS = 8
MLSTM_DV = D_MODEL // MLSTM_HEADS
MLSTM_DQK = MLSTM_DV // 2
MLSTM_CHUNK = 64
GATE_SOFTCAP = 15.0
D_FF = 4 * D_MODEL
RMS_EPS = 1e-6
N_ATTN_LAYERS = (DEPTH + N_MIXERS - 1) // N_MIXERS
N_MLSTM_LAYERS = DEPTH // N_MIXERS

kernel_name = "hybrid_moba_mlstm_sandwich_block"


def rms_norm(x, gain):
    xf = x.astype(jnp.float32)
    y = xf * lax.rsqrt(jnp.mean(xf * xf, axis=-1, keepdims=True) + RMS_EPS)
    return (y * gain.astype(jnp.float32)).astype(x.dtype)


def alibi_slopes(n_heads):
    return jnp.exp2(-8.0 * jnp.arange(1, n_heads + 1, dtype=jnp.float32) / n_heads)


def soft_cap(z):
    return GATE_SOFTCAP * jnp.tanh(z / GATE_SOFTCAP)


def moba_attention(x, w_qkv, w_o):
    bsz, seq, _ = x.shape
    H, dh, blk, qlen = ATT_HEADS, ATT_HEAD_DIM, MOBA_BLOCK, MOBA_QUERY_CHUNK
    f32 = jnp.float32
    q, k, v = jnp.split(x @ w_qkv, 3, axis=-1)

    def to_heads(t):
        return t.reshape(bsz, seq, H, dh).transpose(0, 2, 1, 3)

    q = to_heads(q) * (dh ** -0.5)
    k = to_heads(k)
    v = to_heads(v)
    n_blk = -(-seq // blk)
    pad = n_blk * blk - seq
    k_blk = jnp.pad(k, ((0, 0), (0, 0), (0, pad), (0, 0))).reshape(bsz, H, n_blk, blk, dh)
    v_blk = jnp.pad(v, ((0, 0), (0, 0), (0, pad), (0, 0))).reshape(bsz, H, n_blk, blk, dh)

    k_mean = jnp.mean(k_blk.astype(f32), axis=3)
    gate = jnp.einsum('bhsd,bhnd->bhsn', q.astype(f32), k_mean)
    n_past = jnp.arange(seq) // blk
    is_past = jnp.arange(n_blk)[None, :] < n_past[:, None]
    gate = jnp.where(is_past, gate, -jnp.inf)
    top = min(MOBA_TOPK, n_blk)
    _, sel = lax.top_k(gate, top)
    sel = sel.astype(jnp.int32)

    n_chunk = seq // qlen
    q_c = jnp.moveaxis(q.reshape(bsz, H, n_chunk, qlen, dh), 2, 0)
    sel_c = jnp.moveaxis(sel.reshape(bsz, H, n_chunk, qlen, top), 2, 0)
    slopes = alibi_slopes(H)
    b_idx = jnp.arange(bsz)[:, None, None, None]
    h_idx = jnp.arange(H)[None, :, None, None]
    offs = jnp.arange(blk)

    def attend_chunk(args):
        c, q_blk, sel_blk = args
        t = c * qlen + jnp.arange(qlen)
        own = (c * qlen) // blk
        k_own = lax.dynamic_index_in_dim(k_blk, own, axis=2, keepdims=False)
        v_own = lax.dynamic_index_in_dim(v_blk, own, axis=2, keepdims=False)
        dist_own = (t[:, None] - (own * blk + offs)[None, :]).astype(f32)
        s_own = jnp.einsum('bhqd,bhkd->bhqk', q_blk, k_own).astype(f32) - slopes[:, None, None] * dist_own
        s_own = jnp.where(dist_own >= 0, s_own, -jnp.inf)
        k_sel = k_blk[b_idx, h_idx, sel_blk]
        v_sel = v_blk[b_idx, h_idx, sel_blk]
        dist_sel = (t[:, None, None] - (sel_blk[..., None] * blk + offs)).astype(f32)
        s_sel = jnp.einsum('bhqd,bhqjkd->bhqjk', q_blk, k_sel).astype(f32) - slopes[:, None, None, None] * dist_sel
        slot_ok = jnp.arange(top)[None, :] < (t // blk)[:, None]
        s_sel = jnp.where(slot_ok[:, :, None], s_sel, -jnp.inf)
        scores = jnp.concatenate([s_own, s_sel.reshape(bsz, H, qlen, top * blk)], axis=-1)
        p = jax.nn.softmax(scores, axis=-1).astype(v_blk.dtype)
        p_own = p[..., :blk]
        p_sel = p[..., blk:].reshape(bsz, H, qlen, top, blk)
        return (jnp.einsum('bhqk,bhkd->bhqd', p_own, v_own)
                + jnp.einsum('bhqjk,bhqjkd->bhqd', p_sel, v_sel))

    o = lax.map(attend_chunk, (jnp.arange(n_chunk), q_c, sel_c))
    o = o.transpose(1, 0, 3, 2, 4).reshape(bsz, seq, H * dh)
    return o @ w_o


def mlstm_chunkwise(q, k, v, log_i, log_f):
    bsz, H, seq, dqk = q.shape
    dv = v.shape[-1]
    L = MLSTM_CHUNK
    n_chunk = seq // L

    def chunks(t):
        return jnp.moveaxis(t.reshape(bsz, H, n_chunk, L, *t.shape[3:]), 2, 0)

    causal = jnp.tril(jnp.ones((L, L), dtype=bool))

    def step(carry, inp):
        C, n, m = carry
        qc, kc, vc, ic, fc = inp
        b = jnp.cumsum(fc, axis=-1)
        log_d = jnp.where(causal, b[..., :, None] - b[..., None, :] + ic[..., None, :], -jnp.inf)
        log_inter = b + m[..., None]
        m_t = jnp.maximum(log_inter, jnp.max(log_d, axis=-1))
        d = jnp.exp(log_d - m_t[..., None])
        w_inter = jnp.exp(log_inter - m_t)
        s = jnp.einsum('bhtd,bhsd->bhts', qc, kc) * d
        num = (w_inter[..., None] * jnp.einsum('bhtd,bhdv->bhtv', qc, C)
               + jnp.einsum('bhts,bhsv->bhtv', s, vc))
        den = w_inter * jnp.einsum('bhtd,bhd->bht', qc, n) + jnp.sum(s, axis=-1)
        h = num / jnp.maximum(jnp.abs(den), jnp.exp(-m_t))[..., None]
        b_end = b[..., -1]
        log_w = b_end[..., None] - b + ic
        m_new = jnp.maximum(b_end + m, jnp.max(log_w, axis=-1))
        decay = jnp.exp(b_end + m - m_new)
        w = jnp.exp(log_w - m_new[..., None])
        C = decay[..., None, None] * C + jnp.einsum('bhs,bhsd,bhsv->bhdv', w, kc, vc)
        n = decay[..., None] * n + jnp.einsum('bhs,bhsd->bhd', w, kc)
        return (C, n, m_new), h

    f32 = jnp.float32
    init = (jnp.zeros((bsz, H, dqk, dv), f32), jnp.zeros((bsz, H, dqk), f32), jnp.zeros((bsz, H), f32))
    _, h = lax.scan(step, init, (chunks(q), chunks(k), chunks(v), chunks(log_i), chunks(log_f)))
    return jnp.moveaxis(h, 0, 2).reshape(bsz, H, seq, dv)


def mlstm_mixer(x, w_in, b_gates, norm_h, w_out):
    bsz, seq, _ = x.shape
    H, dqk, dv = MLSTM_HEADS, MLSTM_DQK, MLSTM_DV
    f32 = jnp.float32
    proj = x @ w_in
    q, k, v, o_pre, gate_pre = jnp.split(
        proj, [H * dqk, 2 * H * dqk, 2 * H * dqk + H * dv, 2 * H * dqk + 2 * H * dv], axis=-1)

    def to_heads(t, dim):
        return t.reshape(bsz, seq, H, dim).transpose(0, 2, 1, 3).astype(f32)

    q = to_heads(q, dqk)
    k = to_heads(k, dqk) * (dqk ** -0.5)
    v = to_heads(v, dv)
    gates = soft_cap(gate_pre.astype(f32) + b_gates.astype(f32)).transpose(0, 2, 1)
    log_i = gates[:, :H]
    log_f = jax.nn.log_sigmoid(gates[:, H:])
    h = mlstm_chunkwise(q, k, v, log_i, log_f)
    h = h * lax.rsqrt(jnp.mean(h * h, axis=-1, keepdims=True) + RMS_EPS)
    h = h.transpose(0, 2, 1, 3).reshape(bsz, seq, H * dv) * norm_h.astype(f32)
    y = (jax.nn.sigmoid(o_pre.astype(f32)) * h).astype(x.dtype)
    return y @ w_out


def squared_relu_mlp(x, w_up, w_down):
    return jnp.square(jax.nn.relu(x @ w_up)) @ w_down


def setup_inputs(seed: int = 0) -> dict:
    key = jax.random.key(seed)
    ks = jax.random.split(key, 16)
    f32 = jnp.float32

    def dense(k, shape):
        return jax.random.normal(k, shape, f32) * shape[-2] ** -0.5

    def gain(k, shape):
        return 1.0 + 0.05 * jax.random.normal(k, shape, f32)

    H = MLSTM_HEADS
    mlstm_in = 2 * H * MLSTM_DQK + 2 * H * MLSTM_DV + 2 * H
    i_bias = 0.1 * jax.random.normal(ks[13], (N_MLSTM_LAYERS, H), f32)
    f_bias = 3.0 + 0.5 * jax.random.normal(ks[14], (N_MLSTM_LAYERS, H), f32)
    return {
        "x": jax.random.normal(ks[0], (BATCH, SEQ, D_MODEL), f32),
        "norm_mix_pre": gain(ks[1], (DEPTH, D_MODEL)),
        "norm_mix_post": gain(ks[2], (DEPTH, D_MODEL)),
        "norm_ffn_pre": gain(ks[3], (DEPTH, D_MODEL)),
        "norm_ffn_post": gain(ks[4], (DEPTH, D_MODEL)),
        "w_up": dense(ks[5], (DEPTH, D_MODEL, D_FF)),
        "w_down": dense(ks[6], (DEPTH, D_FF, D_MODEL)),
        "attn_w_qkv": dense(ks[7], (N_ATTN_LAYERS, D_MODEL, 3 * ATT_HEADS * ATT_HEAD_DIM)),
        "attn_w_o": dense(ks[8], (N_ATTN_LAYERS, ATT_HEADS * ATT_HEAD_DIM, D_MODEL)),
        "mlstm_w_in": dense(ks[9], (N_MLSTM_LAYERS, D_MODEL, mlstm_in)),
        "mlstm_b_gates": jnp.concatenate([i_bias, f_bias], axis=-1),
        "mlstm_norm_h": gain(ks[10], (N_MLSTM_LAYERS, H * MLSTM_DV)),
        "mlstm_w_out": dense(ks[11], (N_MLSTM_LAYERS, H * MLSTM_DV, D_MODEL)),
    }


def reference(x, norm_mix_pre, norm_mix_post, norm_ffn_pre, norm_ffn_post, w_up, w_down,
              attn_w_qkv, attn_w_o, mlstm_w_in, mlstm_b_gates, mlstm_norm_h, mlstm_w_out):
    h = x
    for layer in range(DEPTH):
        j = layer // N_MIXERS
        u = rms_norm(h, norm_mix_pre[layer])
        if layer % N_MIXERS == 0:
            u = moba_attention(u, attn_w_qkv[j], attn_w_o[j])
        else:
            u = mlstm_mixer(u, mlstm_w_in[j], mlstm_b_gates[j], mlstm_norm_h[j], mlstm_w_out[j])
        h = h + rms_norm(u, norm_mix_post[layer])
        u = squared_relu_mlp(rms_norm(h, norm_ffn_pre[layer]), w_up[layer], w_down[layer])
        h = h + rms_norm(u, norm_ffn_post[layer])
    return h
```

```cpp
#include <hip/hip_runtime.h>
#include <cstdio>
#include <cstdint>
#include <cmath>
namespace pg8 {
#define PG8_LAS __attribute__((address_space(3)))
typedef unsigned short bf16_t;
typedef short bf16x8 __attribute__((ext_vector_type(8)));
typedef float f32x4 __attribute__((ext_vector_type(4)));
typedef unsigned u32x4 __attribute__((ext_vector_type(4)));
constexpr int BM = 256, BK = 64, HALF = 128, HTB = HALF * BK * 2  , STAGE_BYTES = 8 * HTB, NXCD = 8, WGM = 8;

__host__ __device__ __forceinline__ int lds_byte(int r, int c) { const int st = (r >> 4) * 2 + (c >> 5), rr = r & 15, cc = c & 31, ob = rr * 64 + cc * 2; return st * 1024 + (ob ^ (((ob >> 9) & 1) << 5)); }
__host__ __device__ __forceinline__ void stage_rc(int b, int& R, int& C) { const int st = b / 1024, sb = b % 1024, swz = sb ^ (((sb >> 9) & 1) << 5); R = (st >> 1) * 16 + swz / 64; C = (st & 1) * 32 + (swz % 64) / 2; }
__host__ __device__ __forceinline__ int perm32(int rho) { const int n = rho >> 4, i = rho & 15; return 8 * (i >> 2) + 4 * n + (i & 3); }

struct Unit { int pm, pn; };
struct Gemm { const bf16_t* A; const bf16_t* Bt; int M, N, K; };

struct StaticOrder {
    int nM, nN, nwg, G, c;
    __host__ __device__ void init(int M, int N, int G_, int c_) { nM = M / BM; nN = N / BM; nwg = nM * nN; G = G_; c = c_; }
    __host__ __device__ bool next(int i, Unit& u) const {
        const long L = (long)i * G + c; if (L >= nwg) return false;
        int wgid = (int)L; { const int q = nwg / NXCD, r = nwg % NXCD, xcd = wgid % NXCD, off = wgid / NXCD; wgid = (xcd < r ? xcd * (q + 1) : r * (q + 1) + (xcd - r) * q) + off; }
        const int nig = WGM * nN, gid = wgid / nig, fm = gid * WGM, gsz = (nM - fm) < WGM ? (nM - fm) : WGM;
        u.pm = fm + ((wgid % nig) % gsz); u.pn = (wgid % nig) / gsz; return true;
    }
    __device__ __forceinline__ void a_ready(const Unit&) const {}
    __device__ __forceinline__ void done(const Unit&) const {}
};

__device__ __forceinline__ unsigned cvt_pk_bf16(float lo, float hi) { unsigned r; asm volatile("v_cvt_pk_bf16_f32 %0, %1, %2" : "=v"(r) : "v"(lo), "v"(hi)); return r; }
typedef float f32x2 __attribute__((ext_vector_type(2)));
template <int ACT> struct EpiBf16 {
    static constexpr bool PERM = true, AFTER_DRAIN = false;
    bf16_t* O; int ldc; int split_cols; size_t split_stride; int sc_lo, sc_hi; float scale;
    __device__ __forceinline__ void operator()(const f32x4 (&acc)[2][2][4][2], const Unit& u, int wr, int wc, int fr, int fq) const {
        const int row0 = u.pm * BM + wr * 64 + fr; int colt = u.pn * BM; bf16_t* base = O;
        const float sc = (colt >= sc_lo && colt < sc_hi) ? scale : 1.f;
        if (split_cols) { const int t = colt / split_cols; base += (size_t)t * split_stride; colt -= t * split_cols; }
        const int col0 = colt + wc * 32 + 8 * fq;
#pragma unroll
        for (int ai = 0; ai < 2; ++ai)
#pragma unroll
            for (int m = 0; m < 4; ++m) { bf16_t* rowp = base + (size_t)(row0 + ai * HALF + m * 16) * ldc + col0;
#pragma unroll
                for (int bj = 0; bj < 2; ++bj) { f32x4 v0 = acc[ai][bj][m][0], v1 = acc[ai][bj][m][1];
                    if (ACT == 2) {
#pragma unroll
                        for (int e = 0; e < 4; ++e) { const float a = fmaxf(v0[e], 0.f), b = fmaxf(v1[e], 0.f); v0[e] = a * a; v1[e] = b * b; } }
                    v0 = v0 * sc; v1 = v1 * sc; u32x4 w; w.x = cvt_pk_bf16(v0[0], v0[1]); w.y = cvt_pk_bf16(v0[2], v0[3]); w.z = cvt_pk_bf16(v1[0], v1[1]); w.w = cvt_pk_bf16(v1[2], v1[3]);
                    *(u32x4*)(rowp + bj * HALF) = w; } }
    }
};
struct EpiF32 {
    static constexpr bool PERM = false, AFTER_DRAIN = false;
    float* O; int ldc;
    __device__ __forceinline__ void operator()(const f32x4 (&acc)[2][2][4][2], const Unit& u, int wr, int wc, int fr, int fq) const {
        const int col0 = u.pn * BM + wc * 32 + 4 * fq;
#pragma unroll
        for (int ai = 0; ai < 2; ++ai)
#pragma unroll
            for (int m = 0; m < 4; ++m) { const int r = ai * HALF + wr * 64 + m * 16 + fr; const size_t off = (size_t)(u.pm * BM + r) * ldc + col0;
#pragma unroll
                for (int bj = 0; bj < 2; ++bj)
#pragma unroll
                    for (int n = 0; n < 2; ++n) *(f32x4*)(O + off + bj * HALF + n * 16) = acc[ai][bj][m][n]; }
    }
};

template <class Epi, class Sched, bool ALIGN_EPI = false, bool SP2 = false>
__device__ __forceinline__ void gemm_phase(PG8_LAS unsigned char* lds, const Gemm g, const Sched& S, const Epi& E, int tid_in) {
    int tid_ = tid_in; asm volatile("" : "+v"(tid_));
    const int tid = tid_, wid = __builtin_amdgcn_readfirstlane(tid >> 6), lane = tid & 63, wr = wid >> 2, wc = wid & 3, fr = lane & 15, fq = lane >> 4;
    const int K = g.K, nt = K / BK;
    unsigned voffA[2], voffB[2];
#pragma unroll
    for (int i = 0; i < 2; ++i) { int R, C; stage_rc(tid * 16 + i * 8192, R, C); const int Rb = Epi::PERM ? ((R & ~31) + perm32(R & 31)) : R;
        voffA[i] = (unsigned)(R * K + C) * 2u; voffB[i] = (unsigned)(Rb * K + C) * 2u; }
    const size_t kstep = (size_t)(BK * 2);
    const size_t hstep = (size_t)HALF * K * 2;
    const size_t tstep = 2 * hstep;
    const unsigned ldsw = (unsigned)wid * 1024u;
    const int aoff = lds_byte(wr * 64 + fr, fq * 8), boff = lds_byte(wc * 32 + fr, fq * 8);
#define PG8_SA(b, h) (((b) * 2 + (h)) * HTB)
#define PG8_SB(b, h) ((4 + (b) * 2 + (h)) * HTB)
#define PG8_STAGE(bufoff, gbase, voff) do { _Pragma("unroll") for (int _i = 0; _i < 2; ++_i) \
        __builtin_amdgcn_global_load_lds((const unsigned*)((const char*)(gbase) + (voff)[_i]), (PG8_LAS unsigned*)(lds + (bufoff) + ldsw + _i * 8192), 16, 0, 0); } while (0)
#define PG8_LDA(dst, b, h) do { _Pragma("unroll") for (int m = 0; m < 4; ++m) _Pragma("unroll") for (int k = 0; k < 2; ++k) dst[m][k] = *(const PG8_LAS bf16x8*)(lds + PG8_SA(b, h) + aoff + m * 2048 + k * 1024); } while (0)
#define PG8_LDB(dst, b, h) do { _Pragma("unroll") for (int n = 0; n < 2; ++n) _Pragma("unroll") for (int k = 0; k < 2; ++k) dst[n][k] = *(const PG8_LAS bf16x8*)(lds + PG8_SB(b, h) + boff + n * 2048 + k * 1024); } while (0)
#define PG8_MMA(ai, bj, At, Bt) do { __builtin_amdgcn_s_setprio(1); _Pragma("unroll") for (int m = 0; m < 4; ++m) _Pragma("unroll") for (int n = 0; n < 2; ++n) _Pragma("unroll") for (int k = 0; k < 2; ++k) \
        acc[ai][bj][m][n] = __builtin_amdgcn_mfma_f32_16x16x32_bf16(Bt[n][k], At[m][k], acc[ai][bj][m][n], 0, 0, 0); __builtin_amdgcn_s_setprio(0); } while (0)
#define PG8_WAIT_V(n) asm volatile("s_waitcnt vmcnt(" #n ")" ::: "memory")
#define PG8_WAIT_L(n) asm volatile("s_waitcnt lgkmcnt(" #n ")" ::: "memory")
#define PG8_BAR __builtin_amdgcn_s_barrier()
#define PG8_SCHED __builtin_amdgcn_sched_barrier(0)
    Unit cur, nxt; int ui = 0;
    if (!S.next(0, cur)) return;
    f32x4 acc[2][2][4][2];
#pragma unroll
    for (int a = 0; a < 2; ++a)
#pragma unroll
        for (int b = 0; b < 2; ++b)
#pragma unroll
            for (int m = 0; m < 4; ++m)
#pragma unroll
                for (int n = 0; n < 2; ++n) acc[a][b][m][n] = (f32x4){0.f, 0.f, 0.f, 0.f};
    bf16x8 At[4][2], B0[2][2], B1[2][2];
    const char* cA = (const char*)g.A + (size_t)cur.pm * tstep; const char* cB = (const char*)g.Bt + (size_t)cur.pn * tstep;
    S.a_ready(cur);
    if constexpr (SP2) {
        PG8_STAGE(PG8_SB(0, 0), cB, voffB); PG8_STAGE(PG8_SB(0, 1), cB + hstep, voffB); PG8_STAGE(PG8_SA(0, 0), cA, voffA); PG8_STAGE(PG8_SA(0, 1), cA + hstep, voffA);
        if (wr == 1) PG8_BAR;
        PG8_WAIT_V(2); PG8_BAR;
        PG8_STAGE(PG8_SB(1, 0), cB + kstep, voffB); PG8_STAGE(PG8_SA(1, 0), cA + kstep, voffA); PG8_STAGE(PG8_SB(1, 1), cB + hstep + kstep, voffB);
        PG8_WAIT_V(6); PG8_BAR;
    } else {
        PG8_STAGE(PG8_SB(0, 0), cB, voffB); PG8_STAGE(PG8_SA(0, 0), cA, voffA); PG8_STAGE(PG8_SB(0, 1), cB + hstep, voffB); PG8_STAGE(PG8_SA(0, 1), cA + hstep, voffA);
        if (wr == 1) PG8_BAR;
        PG8_WAIT_V(4); PG8_BAR;
        PG8_STAGE(PG8_SB(1, 0), cB + kstep, voffB); PG8_STAGE(PG8_SA(1, 0), cA + kstep, voffA); PG8_STAGE(PG8_SB(1, 1), cB + hstep + kstep, voffB);
        PG8_WAIT_V(6); PG8_BAR;
    }
    for (;;) {
        const bool has_next = S.next(ui + 1, nxt);
        const char* nA = has_next ? (const char*)g.A + (size_t)nxt.pm * tstep : cA; const char* nB = has_next ? (const char*)g.Bt + (size_t)nxt.pn * tstep : cB;
        for (int t = 0; t < nt; t += 2) {
            const bool last = (t == nt - 2);
            const char* a1 = cA + (size_t)(t + 1) * kstep;
            const char* a2 = last ? nA : cA + (size_t)(t + 2) * kstep; const char* b2 = last ? nB : cB + (size_t)(t + 2) * kstep;
            const char* a3 = a2 + kstep; const char* b3 = b2 + kstep;
            if (last && has_next) S.a_ready(nxt);
            if constexpr (SP2) {
            PG8_LDB(B0, 0, 0); PG8_LDB(B1, 0, 1); PG8_SCHED; PG8_LDA(At, 0, 0); PG8_STAGE(PG8_SA(1, 1), a1 + hstep, voffA);
            PG8_WAIT_V(8); PG8_WAIT_L(0); PG8_BAR; PG8_MMA(0, 0, At, B0); PG8_MMA(0, 1, At, B1); PG8_BAR; PG8_SCHED;
            PG8_LDA(At, 0, 1); PG8_STAGE(PG8_SB(0, 0), b2, voffB); PG8_STAGE(PG8_SB(0, 1), b2 + hstep, voffB); PG8_STAGE(PG8_SA(0, 0), a2, voffA);
            PG8_WAIT_V(8); PG8_WAIT_L(0); PG8_BAR; PG8_MMA(1, 0, At, B0); PG8_MMA(1, 1, At, B1); PG8_BAR; PG8_SCHED;
            PG8_LDB(B0, 1, 0); PG8_LDB(B1, 1, 1); PG8_SCHED; PG8_LDA(At, 1, 0); PG8_STAGE(PG8_SA(0, 1), a2 + hstep, voffA);
            PG8_WAIT_V(8); PG8_WAIT_L(0); PG8_BAR; PG8_MMA(0, 0, At, B0); PG8_MMA(0, 1, At, B1); PG8_BAR; PG8_SCHED;
            PG8_LDA(At, 1, 1); PG8_STAGE(PG8_SB(1, 0), b3, voffB); PG8_STAGE(PG8_SB(1, 1), b3 + hstep, voffB); PG8_STAGE(PG8_SA(1, 0), a3, voffA);
            PG8_WAIT_V(8); PG8_WAIT_L(0); PG8_BAR; PG8_MMA(1, 0, At, B0); PG8_MMA(1, 1, At, B1); PG8_BAR; PG8_SCHED;
            } else {
            PG8_LDB(B0, 0, 0); PG8_SCHED; PG8_LDA(At, 0, 0); PG8_STAGE(PG8_SA(1, 1), a1 + hstep, voffA);
            PG8_WAIT_L(8); PG8_BAR; PG8_WAIT_L(0); PG8_MMA(0, 0, At, B0); PG8_BAR; PG8_SCHED;
            PG8_LDB(B1, 0, 1); PG8_STAGE(PG8_SB(0, 0), b2, voffB);
            PG8_BAR; PG8_WAIT_L(0); PG8_MMA(0, 1, At, B1); PG8_BAR;
            PG8_LDA(At, 0, 1); PG8_STAGE(PG8_SA(0, 0), a2, voffA);
            PG8_BAR; PG8_WAIT_L(0); PG8_MMA(1, 0, At, B0); PG8_BAR; PG8_SCHED;
            PG8_STAGE(PG8_SB(0, 1), b2 + hstep, voffB);
            PG8_WAIT_V(6); PG8_BAR; PG8_MMA(1, 1, At, B1); PG8_BAR;
            PG8_LDB(B0, 1, 0); PG8_SCHED; PG8_LDA(At, 1, 0); PG8_STAGE(PG8_SA(0, 1), a2 + hstep, voffA);
            PG8_WAIT_L(8); PG8_BAR; PG8_WAIT_L(0); PG8_MMA(0, 0, At, B0); PG8_BAR; PG8_SCHED;
            PG8_LDB(B1, 1, 1); PG8_STAGE(PG8_SB(1, 0), b3, voffB);
            PG8_BAR; PG8_WAIT_L(0); PG8_MMA(0, 1, At, B1); PG8_BAR;
            PG8_LDA(At, 1, 1); PG8_STAGE(PG8_SA(1, 0), a3, voffA);
            PG8_BAR; PG8_WAIT_L(0); PG8_MMA(1, 0, At, B0); PG8_BAR; PG8_SCHED;
            PG8_STAGE(PG8_SB(1, 1), b3 + hstep, voffB);
            PG8_WAIT_V(6); PG8_BAR; PG8_MMA(1, 1, At, B1); PG8_BAR;
            }
        }
        if constexpr (ALIGN_EPI) { if (wr == 0) PG8_BAR; }
        if constexpr (!Epi::AFTER_DRAIN) { E(acc, cur, wr, wc, fr, fq); S.done(cur); }
        if (!has_next) break;
#pragma unroll
        for (int a = 0; a < 2; ++a)
#pragma unroll
            for (int b = 0; b < 2; ++b)
#pragma unroll
                for (int m = 0; m < 4; ++m)
#pragma unroll
                    for (int n = 0; n < 2; ++n) acc[a][b][m][n] = (f32x4){0.f, 0.f, 0.f, 0.f};
        cur = nxt; cA = nA; cB = nB; ++ui;
        if constexpr (ALIGN_EPI) { if (wr == 1) PG8_BAR; }
    }
    PG8_WAIT_V(0);
    if constexpr (!ALIGN_EPI) { if (wr == 0) PG8_BAR; }
    PG8_BAR;
    if constexpr (Epi::AFTER_DRAIN) { E.fused(acc, cur, wr, wc, fr, fq, lds, wid, lane); S.done(cur); }
#undef PG8_SA
#undef PG8_SB
#undef PG8_STAGE
#undef PG8_LDA
#undef PG8_LDB
#undef PG8_MMA
#undef PG8_WAIT_V
#undef PG8_WAIT_L
#undef PG8_BAR
#undef PG8_SCHED
}
}
#define GAS __attribute__((address_space(1)))
#define LAS __attribute__((address_space(3)))
typedef unsigned short bf16;
typedef unsigned v4u __attribute__((ext_vector_type(4)));
typedef float f32x4 __attribute__((ext_vector_type(4)));
typedef short bf16x8 __attribute__((ext_vector_type(8)));
typedef GAS unsigned gu32;
typedef GAS unsigned long long gu64;
#define RLX_AGENT __ATOMIC_RELAXED, __HIP_MEMORY_SCOPE_AGENT
#define LDS_WAIT() asm volatile("s_waitcnt lgkmcnt(0)" ::: "memory")
#define VM_WAIT() asm volatile("s_waitcnt vmcnt(0)" ::: "memory")
__device__ __forceinline__ unsigned long long rt() { return __builtin_amdgcn_s_memrealtime(); }
__device__ __forceinline__ unsigned f2bf(float f) { unsigned u = __builtin_bit_cast(unsigned, f); return (u + 0x7fffu + ((u >> 16) & 1u)) >> 16; }
__device__ __forceinline__ unsigned pk2(float lo, float hi) { return f2bf(lo) | (f2bf(hi) << 16); }

#define XB_TMO      128
#define XB_XCNT(j)  (256  + 64 * (j))
#define XB_XSUB(j)  (1280 + 64 * (j))
#define XB_XGEN(j)  (2304 + 64 * (j))
#define XB_TOP      3328
#define XB_TOPGEN   3392
#define XCD_BAR_WORDS 3456
#define XB_SPIN_CAP (1u << 21)

__device__ __forceinline__ unsigned xb_ld(unsigned* p)              { return __hip_atomic_load(p, __ATOMIC_RELAXED, __HIP_MEMORY_SCOPE_AGENT); }
__device__ __forceinline__ unsigned xb_add(unsigned* p, unsigned v) { return __hip_atomic_fetch_add(p, v, __ATOMIC_RELAXED, __HIP_MEMORY_SCOPE_AGENT); }
__device__ __forceinline__ unsigned xb_xcc_id() { return (unsigned)__builtin_amdgcn_s_getreg((3 << 11) | 20) & 0xFu; }
#define XB_SPIN(cond, bar) do { unsigned _sp = 0; while (cond) { __builtin_amdgcn_s_sleep(1); \
    if ((++_sp & 255u) == 0u) { if (xb_ld(&(bar)[XB_TMO])) break; if (_sp > XB_SPIN_CAP) { atomicAdd(&(bar)[XB_TMO], 1u); break; } } } } while (0)

struct XcdBarrier {
    unsigned* bar; unsigned x;
    volatile LAS unsigned* st;
};

__device__ __forceinline__ XcdBarrier xcd_barrier_post(unsigned* bar, volatile LAS unsigned* st) {
    XcdBarrier b; b.bar = bar; b.x = xb_xcc_id(); b.st = st;
    if (threadIdx.x == 0) (void)xb_add(&bar[XB_XCNT(b.x)], 1u);
    return b;
}
__device__ __forceinline__ void xcd_barrier_complete(unsigned* bar, unsigned x, unsigned& nloc, unsigned& nx) {
    const unsigned G = gridDim.x * gridDim.y * gridDim.z;
    unsigned sum, cnt, mine, sp = 0u;
    for (;;) {
        sum = 0u; cnt = 0u; mine = 0u;
#pragma unroll
        for (unsigned j = 0; j < 16; ++j) { const unsigned c = xb_ld(&bar[XB_XCNT(j)]); sum += c; cnt += (c > 0u) ? 1u : 0u; mine = (j == x) ? c : mine; }
        if (sum == G) break;
        __builtin_amdgcn_s_sleep(1);
        if ((++sp & 255u) == 0u) { if (xb_ld(&bar[XB_TMO])) break; if (sp > XB_SPIN_CAP) { atomicAdd(&bar[XB_TMO], 1u); break; } }
    }
    nloc = mine > 0u ? mine : 1u; nx = cnt > 0u ? cnt : 1u;
}

__device__ __forceinline__ void xcd_barrier(const XcdBarrier& b, const bool is_t0  ) {
    asm volatile("s_waitcnt vmcnt(0)" ::: "memory");
    __syncthreads();
    if (is_t0) {
        unsigned* bar = b.bar;
        __builtin_amdgcn_s_waitcnt(0);
        unsigned nloc = b.st[0], nx = b.st[1];
        if (nloc == 0u) { xcd_barrier_complete(bar, b.x, nloc, nx); b.st[0] = nloc; b.st[1] = nx; }
        const unsigned old = xb_add(&bar[XB_XSUB(b.x)], 1u);
        const unsigned gen = old / nloc;
        if (old + 1u == (gen + 1u) * nloc) {
            __builtin_amdgcn_fence(__ATOMIC_RELEASE, "agent");
            asm volatile("s_waitcnt vmcnt(0)" ::: "memory");
            const unsigned og = xb_add(&bar[XB_TOP], 1u);
            const unsigned tg = og / nx;
            if (og + 1u == (tg + 1u) * nx) xb_add(&bar[XB_TOPGEN], 1u);
            else XB_SPIN(xb_ld(&bar[XB_TOPGEN]) == tg, bar);
            __builtin_amdgcn_fence(__ATOMIC_ACQUIRE, "agent");
            xb_add(&bar[XB_XGEN(b.x)], 1u);
            asm volatile("s_waitcnt vmcnt(0)" ::: "memory");
        } else {
            XB_SPIN(xb_ld(&bar[XB_XGEN(b.x)]) == gen, bar);
            __builtin_amdgcn_fence(__ATOMIC_ACQUIRE, "agent");
            asm volatile("s_waitcnt vmcnt(0)" ::: "memory");
        }
    }
    __syncthreads();
}

constexpr int NWAVES = 8, NTHR = NWAVES * 64;
constexpr int BATCH = 2, T = 8192, D = 1024, M = BATCH * T, FF = 4096;
constexpr int NH = 8, DH = 128, BLK = 256, NBLK = T / BLK;
constexpr int LH = 8, DQK = 64, DV = 128, LC = 64, NCH = T / LC;
constexpr int NIN = 2 * LH * DQK + 2 * LH * DV + 2 * LH;
constexpr int NIN_G = 3072;
constexpr float RMS_EPS = 1e-6f, SOFTCAP = 15.0f;
constexpr float LOG2E = 1.4426950408889634f;
constexpr float QSCALE = 0.08838834764831845f * LOG2E;
constexpr float NEG_BIG = -1e30f;

constexpr size_t MiB = 1u << 20;
constexpr size_t WS_CTL = 0, CTL_ZERO_BYTES = 1 * MiB;
constexpr size_t WS_USUM = 1 * MiB;
constexpr size_t WS_KMEAN = 2 * MiB;
constexpr size_t WS_G = 3 * MiB;
constexpr size_t WS_MASK = 5 * MiB;
constexpr size_t WS_GIF = 6 * MiB;
constexpr size_t WS_SMALL = 7 * MiB;
constexpr size_t WS_W = 8 * MiB;
constexpr size_t WS_XN = 32 * MiB;
constexpr size_t WS_QKV = 64 * MiB;
constexpr size_t WS_DC = 160 * MiB;
constexpr size_t WS_U = 192 * MiB;
constexpr size_t WS_END = 256 * MiB;
constexpr int CW_BAR = 4096;

constexpr int RING_BYTES = 131072;
constexpr int LDSCTL_OFF = RING_BYTES, MISC_OFF = LDSCTL_OFF + 320;
constexpr int LDS_BYTES = 147456;

__device__ __forceinline__ float wave_sum(float v) {
#pragma unroll
    for (int o = 1; o < 64; o <<= 1) v += __shfl_xor(v, o);
    return v;
}
__device__ __forceinline__ float wave_max(float v) {
#pragma unroll
    for (int o = 1; o < 64; o <<= 1) v = fmaxf(v, __shfl_xor(v, o));
    return v;
}
__device__ __forceinline__ float bf_lo(unsigned w) { return __uint_as_float(w << 16); }
__device__ __forceinline__ float bf_hi(unsigned w) { return __uint_as_float(w & 0xffff0000u); }
__device__ __forceinline__ float bf1(bf16 h) { return __uint_as_float(((unsigned)h) << 16); }

__device__ __forceinline__ void transpose_item(const float* W, int K, int N, int ld, bf16* WT, LAS float* scr, int item, int lane) {
    const int nblk = N / 32, kb = item / nblk, nb = item % nblk, k0 = 64 * kb, n0 = 32 * nb;
#pragma unroll 8
    for (int i = 0; i < 32; ++i) { const int kk = 2 * i + (lane >> 5); scr[kk * 33 + (lane & 31)] = W[(size_t)(k0 + kk) * ld + n0 + (lane & 31)]; }
    LDS_WAIT(); asm volatile("" ::: "memory");
    const int c = lane & 7;
#pragma unroll
    for (int j = 0; j < 4; ++j) { const int n = (lane >> 3) + 8 * j; const LAS float* s = scr + (8 * c) * 33 + n;
        v4u o; o.x = pk2(s[0 * 33], s[1 * 33]); o.y = pk2(s[2 * 33], s[3 * 33]); o.z = pk2(s[4 * 33], s[5 * 33]); o.w = pk2(s[6 * 33], s[7 * 33]);
        *(GAS v4u*)(WT + (size_t)(n0 + n) * K + k0 + 8 * c) = o; }
    LDS_WAIT(); asm volatile("" ::: "memory");
}
__device__ __forceinline__ void convert_weights(const float* wmix_in, int ld_in, const float* wmix_out, const float* wup, const float* wdown, unsigned char* ws, LAS unsigned char* lds, int gw, int NGW, int wave, int lane) {
    LAS float* scr = (LAS float*)(lds + wave * 16384);
    bf16* W_IN = (bf16*)(ws + WS_W); bf16* W_OUT = (bf16*)(ws + WS_W + 6 * MiB); bf16* W_UP = (bf16*)(ws + WS_W + 8 * MiB); bf16* W_DN = (bf16*)(ws + WS_W + 16 * MiB);
    constexpr int I_IN = (D / 64) * (3072 / 32), I_O = (D / 64) * (D / 32), I_UP = (D / 64) * (FF / 32), I_DN = (FF / 64) * (D / 32);
    for (int it = gw; it < I_IN + I_O + I_UP + I_DN; it += NGW) {
        int r = it;
        if (r < I_IN) { transpose_item(wmix_in, D, 3072, ld_in, W_IN, scr, r, lane); continue; } r -= I_IN;
        if (r < I_O) { transpose_item(wmix_out, D, D, D, W_OUT, scr, r, lane); continue; } r -= I_O;
        if (r < I_UP) { transpose_item(wup, D, FF, FF, W_UP, scr, r, lane); continue; } r -= I_UP;
        transpose_item(wdown, FF, D, D, W_DN, scr, r, lane);
    }
}

__device__ __forceinline__ void rms_row(const float* xrow, const float* gain, int lane, f32x4 (&u)[4]) {
    const GAS f32x4* xr = (const GAS f32x4*)xrow + lane; const GAS f32x4* gr = (const GAS f32x4*)gain + lane;
    float s = 0.f;
#pragma unroll
    for (int j = 0; j < 4; ++j) { u[j] = xr[64 * j]; s += (u[j].x * u[j].x + u[j].y * u[j].y) + (u[j].z * u[j].z + u[j].w * u[j].w); }
    const float r = 1.0f / sqrtf(wave_sum(s) * (1.f / D) + RMS_EPS);
#pragma unroll
    for (int j = 0; j < 4; ++j) { const f32x4 g = gr[64 * j]; u[j] = u[j] * r * g; }
}
__device__ __forceinline__ void store_row_bf16(bf16* orow, int lane, const f32x4 (&u)[4]) {
    GAS unsigned long long* o8 = (GAS unsigned long long*)orow + lane;
#pragma unroll
    for (int j = 0; j < 4; ++j) o8[64 * j] = (unsigned long long)pk2(u[j].x, u[j].y) | ((unsigned long long)pk2(u[j].z, u[j].w) << 32);
}

__device__ __forceinline__ void phase_p0(const float* x, const float* gain, unsigned char* ws, LAS unsigned char* lds, int wg, int G, int tid, int wave, int lane) {
    bf16* XN = (bf16*)(ws + WS_XN); float* USUM = (float*)(ws + WS_USUM);
    LAS f32x4* red = (LAS f32x4*)lds;
    for (int part = wg; part < M / 64; part += G) {
        f32x4 acc[4];
#pragma unroll
        for (int j = 0; j < 4; ++j) acc[j] = (f32x4){0.f, 0.f, 0.f, 0.f};
        for (int i = 0; i < 8; ++i) {
            const int row = part * 64 + wave * 8 + i; f32x4 u[4];
            rms_row(x + (size_t)row * D, gain, lane, u);
            store_row_bf16(XN + (size_t)row * D, lane, u);
#pragma unroll
            for (int j = 0; j < 4; ++j) acc[j] = acc[j] + u[j];
        }
#pragma unroll
        for (int j = 0; j < 4; ++j) red[wave * 256 + 64 * j + lane] = acc[j];
        __syncthreads();
        if (tid < 256) { f32x4 s = red[tid];
#pragma unroll
            for (int w = 1; w < 8; ++w) s = s + red[w * 256 + tid];
            *((GAS f32x4*)(USUM + (size_t)part * 1024) + tid) = s; }
        __syncthreads();
    }
}
__device__ __forceinline__ void phase_kmean(const float* wqkv, unsigned char* ws, int wg, int G, int wave, int lane) {
    const float* USUM = (const float*)(ws + WS_USUM); float* KMEAN = (float*)(ws + WS_KMEAN);
    for (int cg = wg; cg < 256; cg += G) {
        f32x4 w[16];
#pragma unroll
        for (int kk = 0; kk < 16; ++kk) w[kk] = *(const GAS f32x4*)(wqkv + (size_t)(64 * kk + lane) * 3072 + 1024 + 4 * cg);
        for (int bl = 0; bl < 8; ++bl) {
            const int blk = wave * 8 + bl; f32x4 a = (f32x4){0.f, 0.f, 0.f, 0.f};
#pragma unroll
            for (int kk = 0; kk < 16; ++kk) { const int k = 64 * kk + lane; const float* up = USUM + (size_t)(4 * blk) * 1024 + k;
                const float us = (up[0] + up[1024]) + (up[2048] + up[3072]); a = a + w[kk] * us; }
            a.x = wave_sum(a.x); a.y = wave_sum(a.y); a.z = wave_sum(a.z); a.w = wave_sum(a.w);
            if (lane == 0) *(GAS f32x4*)(KMEAN + (size_t)blk * 1024 + 4 * cg) = a * (1.0f / 256.0f);
        }
    }
}
__device__ __forceinline__ void phase_g(const float* wqkv, unsigned char* ws, int wg, int G, int wave, int lane) {
    const float* KMEAN = (const float*)(ws + WS_KMEAN); float* GM = (float*)(ws + WS_G);
    for (int unit = wg; unit < 256; unit += G) {
        const int h = unit & 7, kg = (unit >> 3) & 15, bh = unit >> 7, k = 64 * kg + lane;
        const float* wq = wqkv + (size_t)k * 3072 + h * 128;
        float acc[4] = {0.f, 0.f, 0.f, 0.f};
        for (int dc = 0; dc < 128; dc += 32) {
            f32x4 wv[8];
#pragma unroll
            for (int i = 0; i < 8; ++i) wv[i] = *(const GAS f32x4*)(wq + dc + 4 * i);
#pragma unroll
            for (int bl = 0; bl < 4; ++bl) { const int blk = bh * 32 + wave * 4 + bl; const float* km = KMEAN + (size_t)blk * 1024 + h * 128 + dc;
#pragma unroll
                for (int i = 0; i < 8; ++i) { const f32x4 kv = *(const GAS f32x4*)(km + 4 * i); acc[bl] += (wv[i].x * kv.x + wv[i].y * kv.y) + (wv[i].z * kv.z + wv[i].w * kv.w); } }
        }
#pragma unroll
        for (int bl = 0; bl < 4; ++bl) { const int blk = bh * 32 + wave * 4 + bl, b = blk >> 5, n = blk & 31; GM[((size_t)(b * 256 + h * 32 + n)) * 1024 + k] = acc[bl]; }
    }
}
__device__ __forceinline__ void phase_gate_naive(const float* x, const float* gain, unsigned char* ws, int gw, int NGW, int lane) {
    const float* GM = (const float*)(ws + WS_G); unsigned* MASK = (unsigned*)(ws + WS_MASK);
    for (int m = gw; m < M; m += NGW) {
        const int b = m >> 13, s = m & (T - 1), npast = s >> 8;
        if (npast == 0) { if (lane < 8) MASK[(size_t)m * 8 + lane] = 0u; continue; }
        f32x4 u[4]; rms_row(x + (size_t)m * D, gain, lane, u);
        for (int h = 0; h < NH; ++h) {
            float v0 = -INFINITY, v1 = -INFINITY, v2 = -INFINITY; int i0 = 0, i1 = 0, i2 = 0;
            for (int n = 0; n < npast; ++n) {
                const GAS f32x4* gr = (const GAS f32x4*)(GM + ((size_t)(b * 256 + h * 32 + n)) * 1024) + lane; float a = 0.f;
#pragma unroll
                for (int j = 0; j < 4; ++j) { const f32x4 g = gr[64 * j]; a += (u[j].x * g.x + u[j].y * g.y) + (u[j].z * g.z + u[j].w * g.w); }
                a = wave_sum(a);
                if (a > v0) { v2 = v1; i2 = i1; v1 = v0; i1 = i0; v0 = a; i0 = n; }
                else if (a > v1) { v2 = v1; i2 = i1; v1 = a; i1 = n; }
                else if (a > v2) { v2 = a; i2 = n; }
            }
            unsigned mk = 1u << i0; if (npast > 1) mk |= 1u << i1; if (npast > 2) mk |= 1u << i2;
            if (lane == 0) MASK[(size_t)m * 8 + h] = mk;
        }
    }
}
__device__ __forceinline__ void phase_attn_naive(unsigned char* ws, LAS unsigned char* lds, int gw, int NGW, int wave, int lane) {
    const bf16* Q = (const bf16*)(ws + WS_QKV); const bf16* K = Q + (size_t)M * D; const bf16* V = K + (size_t)M * D;
    const unsigned* MASK = (const unsigned*)(ws + WS_MASK); bf16* O = (bf16*)(ws + WS_XN);
    LAS float* ql = (LAS float*)(lds + wave * 8192); LAS float* pl = ql + 128;
    for (int unit = gw; unit < M * NH; unit += NGW) {
        const int m = unit >> 3, h = unit & 7, b = m >> 13, s = m & (T - 1), own = s >> 8;
        unsigned mk = MASK[(size_t)m * 8 + h];
        const float sl2 = exp2f(-(float)(h + 1)) * LOG2E;
        { const unsigned qv = *(const GAS unsigned*)(Q + (size_t)m * D + h * DH + 2 * lane); ql[2 * lane] = bf_lo(qv); ql[2 * lane + 1] = bf_hi(qv); }
        LDS_WAIT(); asm volatile("" ::: "memory");
        unsigned jbs = (unsigned)own; int nb = 1;
#pragma unroll
        for (int bi = 1; bi < 4; ++bi) { if (mk) { jbs |= (unsigned)__builtin_ctz(mk) << (8 * bi); mk &= mk - 1; nb = bi + 1; } }
        float mx = NEG_BIG;
#pragma unroll 1
        for (int idx = 0; idx < 4 * nb; ++idx) {
            const int bi = idx >> 2, c = idx & 3, jb = (int)((jbs >> (8 * bi)) & 0xffu);
            const int kpos = jb * BLK + c * 64 + lane;
            const GAS v4u* kr = (const GAS v4u*)(K + ((size_t)(b * T + kpos)) * D + h * DH);
            float dot = 0.f;
#pragma unroll
            for (int d8 = 0; d8 < 16; ++d8) { const v4u kw = kr[d8]; const LAS float* qq = ql + 8 * d8;
                dot += (qq[0] * bf_lo(kw.x) + qq[1] * bf_hi(kw.x)) + (qq[2] * bf_lo(kw.y) + qq[3] * bf_hi(kw.y)) + (qq[4] * bf_lo(kw.z) + qq[5] * bf_hi(kw.z)) + (qq[6] * bf_lo(kw.w) + qq[7] * bf_hi(kw.w)); }
            float v = dot - sl2 * (float)(s - kpos);
            if (kpos > s) v = NEG_BIG;
            pl[idx * 64 + lane] = v; mx = fmaxf(mx, v);
        }
        mx = wave_max(mx);
        LDS_WAIT(); asm volatile("" ::: "memory");
        float l = 0.f;
#pragma unroll 1
        for (int idx = 0; idx < 4 * nb; ++idx) { const float p = exp2f(pl[idx * 64 + lane] - mx); l += p; pl[idx * 64 + lane] = p; }
        l = wave_sum(l);
        LDS_WAIT(); asm volatile("" ::: "memory");
        float a0 = 0.f, a1 = 0.f;
#pragma unroll 1
        for (int bi = 0; bi < nb; ++bi) {
            const int jb = (int)((jbs >> (8 * bi)) & 0xffu);
            const GAS unsigned* vr = (const GAS unsigned*)(V + ((size_t)(b * T + jb * BLK)) * D + h * DH) + lane;
            const LAS float* pp = pl + bi * 256;
#pragma unroll 8
            for (int key = 0; key < 256; ++key) { const unsigned vw = vr[(size_t)key * (D / 2)]; const float p = pp[key]; a0 += p * bf_lo(vw); a1 += p * bf_hi(vw); }
        }
        const float il = 1.0f / l;
        *(GAS unsigned*)(O + (size_t)m * D + h * DH + 2 * lane) = pk2(a0 * il, a1 * il);
        LDS_WAIT(); asm volatile("" ::: "memory");
    }
}
template <bool SECOND, bool GATES>
__device__ __forceinline__ void norm_rows(const float* U, const float* hin, float* hout, const float* gpost, const float* gpre, bf16* XN, const LAS float* wg, const float* bg, float* GIF, int gw, int NGW, int lane) {
    for (int m = gw; m < M; m += NGW) {
        f32x4 u[4]; rms_row(U + (size_t)m * D, gpost, lane, u);
        const GAS f32x4* hr = (const GAS f32x4*)(hin + (size_t)m * D) + lane; GAS f32x4* ho = (GAS f32x4*)(hout + (size_t)m * D) + lane;
        float s = 0.f;
#pragma unroll
        for (int j = 0; j < 4; ++j) { u[j] = u[j] + hr[64 * j]; ho[64 * j] = u[j]; s += (u[j].x * u[j].x + u[j].y * u[j].y) + (u[j].z * u[j].z + u[j].w * u[j].w); }
        if (SECOND) {
            const float r = 1.0f / sqrtf(wave_sum(s) * (1.f / D) + RMS_EPS); const GAS f32x4* gr = (const GAS f32x4*)gpre + lane;
#pragma unroll
            for (int j = 0; j < 4; ++j) u[j] = u[j] * r * gr[64 * j];
            store_row_bf16(XN + (size_t)m * D, lane, u);
            if (GATES) {
                float mine = 0.f;
#pragma unroll 1
                for (int g = 0; g < 16; ++g) { float a = 0.f;
#pragma unroll
                    for (int j = 0; j < 4; ++j) { const f32x4 w = *((const LAS f32x4*)(wg + g * 1024) + 64 * j + lane); a += (u[j].x * w.x + u[j].y * w.y) + (u[j].z * w.z + u[j].w * w.w); }
                    a = wave_sum(a); if (lane == g) mine = a; }
                if (lane < 16) { const float z = SOFTCAP * tanhf((mine + bg[lane]) * (1.0f / SOFTCAP));
                    GIF[(size_t)m * 16 + lane] = (lane < 8) ? z : -log1pf(expf(-z)); }
            }
        }
    }
}
__device__ __forceinline__ float scan_add(float v, int lane) {
#pragma unroll
    for (int o = 1; o < 64; o <<= 1) { const float t = __shfl_up(v, o); if (lane >= o) v += t; }
    return v;
}
__device__ __forceinline__ float scan_max(float v, int lane) {
#pragma unroll
    for (int o = 1; o < 64; o <<= 1) { const float t = __shfl_up(v, o); if (lane >= o) v = fmaxf(v, t); }
    return v;
}
__device__ __forceinline__ void phase_mlstm_a(unsigned char* ws, int gw, int NGW, int lane) {
    const bf16* QK = (const bf16*)(ws + WS_QKV); const float* GIF = (const float*)(ws + WS_GIF);
    float* DC = (float*)(ws + WS_DC); float* BEND = (float*)(ws + WS_SMALL); float* MLOC = BEND + 2048; float* DN = BEND + 3 * 2048;
    float* BCUM = (float*)(ws + WS_USUM); float* GMX = BCUM + (size_t)M * 8;
    for (int unit = gw; unit < 16 * NCH; unit += NGW) {
        const int bh = unit >> 7, c = unit & 127, b = bh >> 3, h = bh & 7, tok0 = b * T + c * LC;
        const float lf = GIF[(size_t)(tok0 + lane) * 16 + 8 + h], li = GIF[(size_t)(tok0 + lane) * 16 + h];
        const float bc = scan_add(lf, lane), bend = __shfl(bc, 63), lw = bend - bc + li, mloc = wave_max(lw), w = expf(lw - mloc);
        BCUM[(size_t)(tok0 + lane) * 8 + h] = bc; GMX[(size_t)(tok0 + lane) * 8 + h] = scan_max(li - bc, lane);
        float acc[128];
#pragma unroll
        for (int v = 0; v < 128; ++v) acc[v] = 0.f;
        float dn = 0.f;
#pragma unroll 1
        for (int s = 0; s < LC; ++s) {
            const float wsv = __shfl(w, s);
            const bf16* row = QK + (size_t)(tok0 + s) * NIN_G;
            const float kw = wsv * bf1(row[512 + h * DQK + lane]); dn += kw;
            const GAS v4u* vr = (const GAS v4u*)(row + 1024 + h * DV);
#pragma unroll
            for (int i = 0; i < 16; ++i) { const v4u vw = vr[i];
                acc[8 * i + 0] += kw * bf_lo(vw.x); acc[8 * i + 1] += kw * bf_hi(vw.x); acc[8 * i + 2] += kw * bf_lo(vw.y); acc[8 * i + 3] += kw * bf_hi(vw.y);
                acc[8 * i + 4] += kw * bf_lo(vw.z); acc[8 * i + 5] += kw * bf_hi(vw.z); acc[8 * i + 6] += kw * bf_lo(vw.w); acc[8 * i + 7] += kw * bf_hi(vw.w);
                if (i == 7) asm volatile("" ::: "memory"); }
        }
        GAS f32x4* dst = (GAS f32x4*)(DC + ((size_t)unit * 64 + lane) * 128);
#pragma unroll
        for (int i = 0; i < 32; ++i) dst[i] = (f32x4){acc[4 * i], acc[4 * i + 1], acc[4 * i + 2], acc[4 * i + 3]};
        DN[(size_t)unit * 64 + lane] = dn;
        if (lane == 0) { BEND[unit] = bend; MLOC[unit] = mloc; }
    }
}
__device__ __forceinline__ void phase_mlstm_b(unsigned char* ws, int gtid, int NT) {
    float* DC = (float*)(ws + WS_DC); float* BEND = (float*)(ws + WS_SMALL); float* MLOC = BEND + 2048; float* MST = BEND + 2 * 2048; float* DN = BEND + 3 * 2048;
    for (int e = gtid; e < 16 * 8192 + 16 * 64; e += NT) {
        int bh; float* base; int stride; bool wm = false;
        if (e < 16 * 8192) { bh = e >> 13; base = DC + (size_t)bh * 128 * 8192 + (e & 8191); stride = 8192; }
        else { const int e2 = e - 16 * 8192; bh = e2 >> 6; base = DN + (size_t)bh * 128 * 64 + (e2 & 63); stride = 64; wm = (e2 & 63) == 0; }
        float mcur = 0.f, st = 0.f;
        for (int c0 = 0; c0 < NCH; c0 += 8) {
            float xv[8], be[8], ml[8];
#pragma unroll
            for (int i = 0; i < 8; ++i) { xv[i] = base[(size_t)(c0 + i) * stride]; be[i] = BEND[bh * 128 + c0 + i]; ml[i] = MLOC[bh * 128 + c0 + i]; }
#pragma unroll
            for (int i = 0; i < 8; ++i) {
                base[(size_t)(c0 + i) * stride] = st; if (wm) MST[bh * 128 + c0 + i] = mcur;
                const float mn = fmaxf(be[i] + mcur, ml[i]);
                st = expf(be[i] + mcur - mn) * st + expf(ml[i] - mn) * xv[i]; mcur = mn;
            }
        }
    }
}
__device__ __forceinline__ void phase_mlstm_c(const float* norm_h, unsigned char* ws, LAS unsigned char* lds, int gw, int NGW, int wave, int lane) {
    const bf16* QK = (const bf16*)(ws + WS_QKV); const float* GIF = (const float*)(ws + WS_GIF);
    const float* DC = (const float*)(ws + WS_DC); const float* BEND = (const float*)(ws + WS_SMALL); const float* MST = BEND + 2 * 2048; const float* DN = BEND + 3 * 2048;
    bf16* Y = (bf16*)(ws + WS_XN); const float* BCUM = (const float*)(ws + WS_USUM); const float* GMX = BCUM + (size_t)M * 8;
    LAS float* sl = (LAS float*)(lds + wave * 16384);
    for (int unit = gw; unit < 16 * NCH; unit += NGW) {
        const int bh = unit >> 7, c = unit & 127, b = bh >> 3, h = bh & 7, tok0 = b * T + c * LC, tok = tok0 + lane;
        const float li = GIF[(size_t)tok * 16 + h];
        const float bc = BCUM[(size_t)tok * 8 + h], g = li - bc, mxp = GMX[(size_t)tok * 8 + h], mc = MST[unit];
        const float mmax = fmaxf(mc, mxp), winter = expf(mc - mmax);
        float den = 0.f;
        {
            float q[64];
            const GAS v4u* qr = (const GAS v4u*)(QK + (size_t)tok * NIN_G + h * DQK);
#pragma unroll
            for (int i = 0; i < 8; ++i) { const v4u w = qr[i]; q[8 * i] = bf_lo(w.x); q[8 * i + 1] = bf_hi(w.x); q[8 * i + 2] = bf_lo(w.y); q[8 * i + 3] = bf_hi(w.y);
                q[8 * i + 4] = bf_lo(w.z); q[8 * i + 5] = bf_hi(w.z); q[8 * i + 6] = bf_lo(w.w); q[8 * i + 7] = bf_hi(w.w); }
    #pragma unroll 1
        for (int s = 0; s < LC; ++s) {
                const GAS v4u* kr = (const GAS v4u*)(QK + (size_t)(tok0 + s) * NIN_G + 512 + h * DQK); float dot = 0.f;
#pragma unroll
                for (int i = 0; i < 8; ++i) { const v4u kw = kr[i];
                    dot += (q[8 * i] * bf_lo(kw.x) + q[8 * i + 1] * bf_hi(kw.x)) + (q[8 * i + 2] * bf_lo(kw.y) + q[8 * i + 3] * bf_hi(kw.y)) + (q[8 * i + 4] * bf_lo(kw.z) + q[8 * i + 5] * bf_hi(kw.z)) + (q[8 * i + 6] * bf_lo(kw.w) + q[8 * i + 7] * bf_hi(kw.w)); }
                const float gs = __shfl(g, s); const float sv = (s <= lane) ? dot * expf(gs - mmax) : 0.f; den += sv;
                sl[s * 64 + lane] = sv;
            }
        }
        LDS_WAIT(); asm volatile("" ::: "memory");
        float acc[128];
#pragma unroll
        for (int v = 0; v < 128; ++v) acc[v] = 0.f;
#pragma unroll 1
        for (int s = 0; s < LC; ++s) {
            const float sv = sl[s * 64 + lane];
            const GAS v4u* vr = (const GAS v4u*)(QK + (size_t)(tok0 + s) * NIN_G + 1024 + h * DV);
#pragma unroll
            for (int i = 0; i < 16; ++i) { const v4u vw = vr[i];
                acc[8 * i + 0] += sv * bf_lo(vw.x); acc[8 * i + 1] += sv * bf_hi(vw.x); acc[8 * i + 2] += sv * bf_lo(vw.y); acc[8 * i + 3] += sv * bf_hi(vw.y);
                acc[8 * i + 4] += sv * bf_lo(vw.z); acc[8 * i + 5] += sv * bf_hi(vw.z); acc[8 * i + 6] += sv * bf_lo(vw.w); acc[8 * i + 7] += sv * bf_hi(vw.w);
                if (i == 7) asm volatile("" ::: "memory"); }
        }
        float qn = 0.f;
#pragma unroll 1
        for (int d = 0; d < DQK; ++d) {
            const float qd = bf1(QK[(size_t)tok * NIN_G + h * DQK + d]); qn += qd * DN[(size_t)unit * 64 + d]; const float qw = qd * winter;
            const GAS f32x4* cr = (const GAS f32x4*)(DC + ((size_t)unit * 64 + d) * 128);
#pragma unroll
            for (int i = 0; i < 32; ++i) { const f32x4 cv = cr[i]; acc[4 * i] += qw * cv.x; acc[4 * i + 1] += qw * cv.y; acc[4 * i + 2] += qw * cv.z; acc[4 * i + 3] += qw * cv.w;
                if ((i & 7) == 7) asm volatile("" ::: "memory"); }
        }
        den = winter * qn + den;
        const float inv = 1.0f / fmaxf(fabsf(den), expf(-(bc + mmax)));
        float ssq = 0.f;
#pragma unroll
        for (int v = 0; v < 128; ++v) { acc[v] *= inv; ssq += acc[v] * acc[v]; }
        const float rn = 1.0f / sqrtf(ssq * (1.0f / DV) + RMS_EPS);
        const GAS v4u* orow = (const GAS v4u*)(QK + (size_t)tok * NIN_G + 2048 + h * DV); GAS v4u* yrow = (GAS v4u*)(Y + (size_t)tok * D + h * DV);
        const float* nh = norm_h + h * DV;
#pragma unroll
        for (int i = 0; i < 16; ++i) { const v4u ow = orow[i]; float o[8] = {bf_lo(ow.x), bf_hi(ow.x), bf_lo(ow.y), bf_hi(ow.y), bf_lo(ow.z), bf_hi(ow.z), bf_lo(ow.w), bf_hi(ow.w)}; float y[8];
#pragma unroll
            for (int e = 0; e < 8; ++e) y[e] = acc[8 * i + e] * rn * nh[8 * i + e] * (1.0f / (1.0f + expf(-o[e])));
            v4u yw; yw.x = pk2(y[0], y[1]); yw.y = pk2(y[2], y[3]); yw.z = pk2(y[4], y[5]); yw.w = pk2(y[6], y[7]); yrow[i] = yw;
            if ((i & 3) == 3) asm volatile("" ::: "memory"); }
        LDS_WAIT(); asm volatile("" ::: "memory");
    }
}

struct Args { const float* in[13]; float* out; unsigned char* ws; };
__global__ void __launch_bounds__(NTHR, 2) fwd_kernel(Args args) {
    extern __shared__ __attribute__((aligned(16))) unsigned char lds_raw[];
    LAS unsigned char* lds = (LAS unsigned char*)lds_raw;
    volatile LAS unsigned* MISC = (volatile LAS unsigned*)(lds + MISC_OFF);
    const int wave = __builtin_amdgcn_readfirstlane((int)threadIdx.x >> 6);
    const int G = gridDim.x, wg = blockIdx.x;
#define FRESH int lane_ = (int)__lane_id(); asm volatile("" : "+v"(lane_)); const int lane = lane_; const int tid = wave * 64 + lane; (void)tid;
    const int gw = wg * NWAVES + wave, NGW = G * NWAVES;
    unsigned char* ws = args.ws;
    gu32* ctl = (gu32*)(ws + WS_CTL);
    { FRESH for (int u = tid; u < (LDS_BYTES - LDSCTL_OFF) / 4; u += NTHR) ((LAS unsigned*)(lds + LDSCTL_OFF))[u] = 0u; }
    __syncthreads();
    XcdBarrier bar = xcd_barrier_post((unsigned*)(ctl + CW_BAR), MISC + 8);
#define GRID_BAR() do { FRESH xcd_barrier(bar, tid == 0); } while (0)
    const float* x = args.in[0]; const float* g_mix_pre = args.in[1]; const float* g_mix_post = args.in[2]; const float* g_ffn_pre = args.in[3]; const float* g_ffn_post = args.in[4];
    const float* w_up = args.in[5]; const float* w_down = args.in[6]; const float* w_qkv = args.in[7]; const float* w_o = args.in[8];
    const float* w_in = args.in[9]; const float* b_gates = args.in[10]; const float* norm_h = args.in[11]; const float* w_out = args.in[12];
    float* out = args.out;
    bf16* W_IN = (bf16*)(ws + WS_W); bf16* W_OUT = (bf16*)(ws + WS_W + 6 * MiB); bf16* W_UP = (bf16*)(ws + WS_W + 8 * MiB); bf16* W_DN = (bf16*)(ws + WS_W + 16 * MiB);
    bf16* XN = (bf16*)(ws + WS_XN); bf16* QKV = (bf16*)(ws + WS_QKV); float* U = (float*)(ws + WS_U);

    { FRESH convert_weights(w_qkv, 3072, w_o, w_up, w_down, ws, lds, gw, NGW, wave, lane); }
    __syncthreads();
    { FRESH phase_p0(x, g_mix_pre, ws, lds, wg, G, tid, wave, lane); }
    GRID_BAR();
    {
        pg8::Gemm g{XN, W_IN, M, 3 * D, D}; pg8::StaticOrder S; S.init(M, 3 * D, G, wg);
        pg8::EpiBf16<0> E{QKV, D, D, (size_t)M * D, 0, D, QSCALE};
        FRESH pg8::gemm_phase<pg8::EpiBf16<0>, pg8::StaticOrder, true, true>(lds, g, S, E, tid);
    }
    { FRESH phase_kmean(w_qkv, ws, wg, G, wave, lane); }
    GRID_BAR();
    { FRESH phase_g(w_qkv, ws, wg, G, wave, lane); }
    GRID_BAR();
    { FRESH phase_gate_naive(x, g_mix_pre, ws, gw, NGW, lane); }
    GRID_BAR();
    { FRESH phase_attn_naive(ws, lds, gw, NGW, wave, lane); }
    GRID_BAR();
    {
        pg8::Gemm g{XN, W_OUT, M, D, D}; pg8::StaticOrder S; S.init(M, D, G, wg);
        pg8::EpiF32 E{U, D};
        FRESH pg8::gemm_phase<pg8::EpiF32, pg8::StaticOrder, true, true>(lds, g, S, E, tid);
    }
    GRID_BAR();
    { FRESH norm_rows<true, false>(U, x, out, g_mix_post, g_ffn_pre, XN, nullptr, nullptr, nullptr, gw, NGW, lane); }
    GRID_BAR();
    {
        pg8::Gemm g{XN, W_UP, M, FF, D}; pg8::StaticOrder S; S.init(M, FF, G, wg);
        pg8::EpiBf16<2> E{QKV, FF, 0, 0, 0, 0, 1.f};
        FRESH pg8::gemm_phase<pg8::EpiBf16<2>, pg8::StaticOrder, true, true>(lds, g, S, E, tid);
    }
    GRID_BAR();
    {
        pg8::Gemm g{QKV, W_DN, M, D, FF}; pg8::StaticOrder S; S.init(M, D, G, wg);
        pg8::EpiF32 E{U, D};
        FRESH pg8::gemm_phase<pg8::EpiF32, pg8::StaticOrder, true, true>(lds, g, S, E, tid);
    }
    GRID_BAR();
    { FRESH convert_weights(w_in, NIN, w_out, w_up + (size_t)D * FF, w_down + (size_t)D * FF, ws, lds, gw, NGW, wave, lane); }
    __syncthreads();
    {
        LAS float* wgl = (LAS float*)lds;
        { FRESH for (int e = tid; e < 16 * 1024; e += NTHR) { const int k = e >> 4, gg = e & 15; wgl[gg * 1024 + k] = w_in[(size_t)k * NIN + NIN_G + gg]; } }
        __syncthreads();
        { FRESH norm_rows<true, true>(U, out, out, g_ffn_post, g_mix_pre + D, XN, wgl, b_gates, (float*)(ws + WS_GIF), gw, NGW, lane); }
    }
    GRID_BAR();
    {
        pg8::Gemm g{XN, W_IN, M, NIN_G, D}; pg8::StaticOrder S; S.init(M, NIN_G, G, wg);
        pg8::EpiBf16<0> E{QKV, NIN_G, 0, 0, 512, 1024, 0.125f};
        FRESH pg8::gemm_phase<pg8::EpiBf16<0>, pg8::StaticOrder, true, true>(lds, g, S, E, tid);
    }
    GRID_BAR();
    { FRESH phase_mlstm_a(ws, gw, NGW, lane); }
    GRID_BAR();
    { FRESH phase_mlstm_b(ws, wg * NTHR + tid, G * NTHR); }
    GRID_BAR();
    { FRESH phase_mlstm_c(norm_h, ws, lds, gw, NGW, wave, lane); }
    GRID_BAR();
    {
        pg8::Gemm g{XN, W_OUT, M, D, D}; pg8::StaticOrder S; S.init(M, D, G, wg);
        pg8::EpiF32 E{U, D};
        FRESH pg8::gemm_phase<pg8::EpiF32, pg8::StaticOrder, true, true>(lds, g, S, E, tid);
    }
    GRID_BAR();
    { FRESH norm_rows<true, false>(U, out, out, g_mix_post + D, g_ffn_pre + D, XN, nullptr, nullptr, nullptr, gw, NGW, lane); }
    GRID_BAR();
    {
        pg8::Gemm g{XN, W_UP, M, FF, D}; pg8::StaticOrder S; S.init(M, FF, G, wg);
        pg8::EpiBf16<2> E{QKV, FF, 0, 0, 0, 0, 1.f};
        FRESH pg8::gemm_phase<pg8::EpiBf16<2>, pg8::StaticOrder, true, true>(lds, g, S, E, tid);
    }
    GRID_BAR();
    {
        pg8::Gemm g{QKV, W_DN, M, D, FF}; pg8::StaticOrder S; S.init(M, D, G, wg);
        pg8::EpiF32 E{U, D};
        FRESH pg8::gemm_phase<pg8::EpiF32, pg8::StaticOrder, true, true>(lds, g, S, E, tid);
    }
    GRID_BAR();
    { FRESH norm_rows<false, false>(U, out, out, g_ffn_post + D, nullptr, nullptr, nullptr, nullptr, nullptr, gw, NGW, lane); }
}

extern "C" void kernel_launch(void* const* d_in, const int* in_sizes, int n_in, void* d_out, int out_size, void* d_ws, size_t ws_size, hipStream_t stream) {
    static int grid = 0;
    if (grid == 0) {
        if (n_in != 13 || in_sizes[0] != M * D || out_size != M * D || ws_size < WS_END) { fprintf(stderr, "kernel_launch: unexpected shapes (n_in %d in0 %d out %d ws %zu)\n", n_in, n_in > 0 ? in_sizes[0] : -1, out_size, ws_size); grid = -1; return; }
        int dev = 0, cus = 0;
        if (hipGetDevice(&dev) != hipSuccess || hipDeviceGetAttribute(&cus, hipDeviceAttributeMultiprocessorCount, dev) != hipSuccess) { grid = -1; return; }
        if (hipFuncSetAttribute((const void*)fwd_kernel, hipFuncAttributeMaxDynamicSharedMemorySize, LDS_BYTES) != hipSuccess) { fprintf(stderr, "kernel_launch: hipFuncSetAttribute failed\n"); grid = -1; return; }
        int per_cu = 0;
        if (hipOccupancyMaxActiveBlocksPerMultiprocessor(&per_cu, (const void*)fwd_kernel, NTHR, LDS_BYTES) != hipSuccess || per_cu < 1) fprintf(stderr, "kernel_launch: occupancy query reports %d\n", per_cu);
        (void)hipGetLastError();
        grid = cus;
    }
    if (grid < 0) return;
    if (hipMemsetAsync((char*)d_ws + WS_CTL, 0, CTL_ZERO_BYTES, stream) != hipSuccess) return;
    Args a{};
    for (int i = 0; i < 13; ++i) a.in[i] = (const float*)d_in[i];
    a.out = (float*)d_out; a.ws = (unsigned char*)d_ws;
    hipLaunchKernelGGL(fwd_kernel, dim3(grid), dim3(NTHR), LDS_BYTES, stream, a);
}
```

```cpp
#include <hip/hip_runtime.h>
#include <cstdio>
#include <cstdint>
#include <cmath>
namespace pg8 {
#define PG8_LAS __attribute__((address_space(3)))
typedef unsigned short bf16_t;
typedef short bf16x8 __attribute__((ext_vector_type(8)));
typedef float f32x4 __attribute__((ext_vector_type(4)));
typedef unsigned u32x4 __attribute__((ext_vector_type(4)));
constexpr int BM = 256, BK = 64, HALF = 128, HTB = HALF * BK * 2  , STAGE_BYTES = 8 * HTB, NXCD = 8, WGM = 8;

__host__ __device__ __forceinline__ int lds_byte(int r, int c) { const int st = (r >> 4) * 2 + (c >> 5), rr = r & 15, cc = c & 31, ob = rr * 64 + cc * 2; return st * 1024 + (ob ^ (((ob >> 9) & 1) << 5)); }
__host__ __device__ __forceinline__ void stage_rc(int b, int& R, int& C) { const int st = b / 1024, sb = b % 1024, swz = sb ^ (((sb >> 9) & 1) << 5); R = (st >> 1) * 16 + swz / 64; C = (st & 1) * 32 + (swz % 64) / 2; }
__host__ __device__ __forceinline__ int perm32(int rho) { const int n = rho >> 4, i = rho & 15; return 8 * (i >> 2) + 4 * n + (i & 3); }

struct Unit { int pm, pn; };
struct Gemm { const bf16_t* A; const bf16_t* Bt; int M, N, K; };

struct StaticOrder {
    int nM, nN, nwg, G, c;
    __host__ __device__ void init(int M, int N, int G_, int c_) { nM = M / BM; nN = N / BM; nwg = nM * nN; G = G_; c = c_; }
    __host__ __device__ bool next(int i, Unit& u) const {
        const long L = (long)i * G + c; if (L >= nwg) return false;
        int wgid = (int)L; { const int q = nwg / NXCD, r = nwg % NXCD, xcd = wgid % NXCD, off = wgid / NXCD; wgid = (xcd < r ? xcd * (q + 1) : r * (q + 1) + (xcd - r) * q) + off; }
        const int nig = WGM * nN, gid = wgid / nig, fm = gid * WGM, gsz = (nM - fm) < WGM ? (nM - fm) : WGM;
        u.pm = fm + ((wgid % nig) % gsz); u.pn = (wgid % nig) / gsz; return true;
    }
    __device__ __forceinline__ void a_ready(const Unit&) const {}
    __device__ __forceinline__ void done(const Unit&) const {}
};

__device__ __forceinline__ unsigned cvt_pk_bf16(float lo, float hi) { unsigned r; asm volatile("v_cvt_pk_bf16_f32 %0, %1, %2" : "=v"(r) : "v"(lo), "v"(hi)); return r; }
typedef float f32x2 __attribute__((ext_vector_type(2)));
template <int ACT> struct EpiBf16 {
    static constexpr bool PERM = true, AFTER_DRAIN = false;
    bf16_t* O; int ldc; int split_cols; size_t split_stride; int sc_lo, sc_hi; float scale;
    __device__ __forceinline__ void operator()(const f32x4 (&acc)[2][2][4][2], const Unit& u, int wr, int wc, int fr, int fq) const {
        const int row0 = u.pm * BM + wr * 64 + fr; int colt = u.pn * BM; bf16_t* base = O;
        const float sc = (colt >= sc_lo && colt < sc_hi) ? scale : 1.f;
        if (split_cols) { const int t = colt / split_cols; base += (size_t)t * split_stride; colt -= t * split_cols; }
        const int col0 = colt + wc * 32 + 8 * fq;
#pragma unroll
        for (int ai = 0; ai < 2; ++ai)
#pragma unroll
            for (int m = 0; m < 4; ++m) { bf16_t* rowp = base + (size_t)(row0 + ai * HALF + m * 16) * ldc + col0;
#pragma unroll
                for (int bj = 0; bj < 2; ++bj) { f32x4 v0 = acc[ai][bj][m][0], v1 = acc[ai][bj][m][1];
                    if (ACT == 2) {
#pragma unroll
                        for (int e = 0; e < 4; ++e) { const float a = fmaxf(v0[e], 0.f), b = fmaxf(v1[e], 0.f); v0[e] = a * a; v1[e] = b * b; } }
                    v0 = v0 * sc; v1 = v1 * sc; u32x4 w; w.x = cvt_pk_bf16(v0[0], v0[1]); w.y = cvt_pk_bf16(v0[2], v0[3]); w.z = cvt_pk_bf16(v1[0], v1[1]); w.w = cvt_pk_bf16(v1[2], v1[3]);
                    *(u32x4*)(rowp + bj * HALF) = w; } }
    }
};
struct EpiF32 {
    static constexpr bool PERM = false, AFTER_DRAIN = false;
    float* O; int ldc;
    __device__ __forceinline__ void operator()(const f32x4 (&acc)[2][2][4][2], const Unit& u, int wr, int wc, int fr, int fq) const {
        const int col0 = u.pn * BM + wc * 32 + 4 * fq;
#pragma unroll
        for (int ai = 0; ai < 2; ++ai)
#pragma unroll
            for (int m = 0; m < 4; ++m) { const int r = ai * HALF + wr * 64 + m * 16 + fr; const size_t off = (size_t)(u.pm * BM + r) * ldc + col0;
#pragma unroll
                for (int bj = 0; bj < 2; ++bj)
#pragma unroll
                    for (int n = 0; n < 2; ++n) *(f32x4*)(O + off + bj * HALF + n * 16) = acc[ai][bj][m][n]; }
    }
};

template <class Epi, class Sched, bool ALIGN_EPI = false, bool SP2 = false>
__device__ __forceinline__ void gemm_phase(PG8_LAS unsigned char* lds, const Gemm g, const Sched& S, const Epi& E, int tid_in) {
    int tid_ = tid_in; asm volatile("" : "+v"(tid_));
    const int tid = tid_, wid = __builtin_amdgcn_readfirstlane(tid >> 6), lane = tid & 63, wr = wid >> 2, wc = wid & 3, fr = lane & 15, fq = lane >> 4;
    const int K = g.K, nt = K / BK;
    unsigned voffA[2], voffB[2];
#pragma unroll
    for (int i = 0; i < 2; ++i) { int R, C; stage_rc(tid * 16 + i * 8192, R, C); const int Rb = Epi::PERM ? ((R & ~31) + perm32(R & 31)) : R;
        voffA[i] = (unsigned)(R * K + C) * 2u; voffB[i] = (unsigned)(Rb * K + C) * 2u; }
    const size_t kstep = (size_t)(BK * 2);
    const size_t hstep = (size_t)HALF * K * 2;
    const size_t tstep = 2 * hstep;
    const unsigned ldsw = (unsigned)wid * 1024u;
    const int aoff = lds_byte(wr * 64 + fr, fq * 8), boff = lds_byte(wc * 32 + fr, fq * 8);
#define PG8_SA(b, h) (((b) * 2 + (h)) * HTB)
#define PG8_SB(b, h) ((4 + (b) * 2 + (h)) * HTB)
#define PG8_STAGE(bufoff, gbase, voff) do { _Pragma("unroll") for (int _i = 0; _i < 2; ++_i) \
        __builtin_amdgcn_global_load_lds((const unsigned*)((const char*)(gbase) + (voff)[_i]), (PG8_LAS unsigned*)(lds + (bufoff) + ldsw + _i * 8192), 16, 0, 0); } while (0)
#define PG8_LDA(dst, b, h) do { _Pragma("unroll") for (int m = 0; m < 4; ++m) _Pragma("unroll") for (int k = 0; k < 2; ++k) dst[m][k] = *(const PG8_LAS bf16x8*)(lds + PG8_SA(b, h) + aoff + m * 2048 + k * 1024); } while (0)
#define PG8_LDB(dst, b, h) do { _Pragma("unroll") for (int n = 0; n < 2; ++n) _Pragma("unroll") for (int k = 0; k < 2; ++k) dst[n][k] = *(const PG8_LAS bf16x8*)(lds + PG8_SB(b, h) + boff + n * 2048 + k * 1024); } while (0)
#define PG8_MMA(ai, bj, At, Bt) do { __builtin_amdgcn_s_setprio(1); _Pragma("unroll") for (int m = 0; m < 4; ++m) _Pragma("unroll") for (int n = 0; n < 2; ++n) _Pragma("unroll") for (int k = 0; k < 2; ++k) \
        acc[ai][bj][m][n] = __builtin_amdgcn_mfma_f32_16x16x32_bf16(Bt[n][k], At[m][k], acc[ai][bj][m][n], 0, 0, 0); __builtin_amdgcn_s_setprio(0); } while (0)
#define PG8_WAIT_V(n) asm volatile("s_waitcnt vmcnt(" #n ")" ::: "memory")
#define PG8_WAIT_L(n) asm volatile("s_waitcnt lgkmcnt(" #n ")" ::: "memory")
#define PG8_BAR __builtin_amdgcn_s_barrier()
#define PG8_SCHED __builtin_amdgcn_sched_barrier(0)
    Unit cur, nxt; int ui = 0;
    if (!S.next(0, cur)) return;
    f32x4 acc[2][2][4][2];
#pragma unroll
    for (int a = 0; a < 2; ++a)
#pragma unroll
        for (int b = 0; b < 2; ++b)
#pragma unroll
            for (int m = 0; m < 4; ++m)
#pragma unroll
                for (int n = 0; n < 2; ++n) acc[a][b][m][n] = (f32x4){0.f, 0.f, 0.f, 0.f};
    bf16x8 At[4][2], B0[2][2], B1[2][2];
    const char* cA = (const char*)g.A + (size_t)cur.pm * tstep; const char* cB = (const char*)g.Bt + (size_t)cur.pn * tstep;
    S.a_ready(cur);
    if constexpr (SP2) {
        PG8_STAGE(PG8_SB(0, 0), cB, voffB); PG8_STAGE(PG8_SB(0, 1), cB + hstep, voffB); PG8_STAGE(PG8_SA(0, 0), cA, voffA); PG8_STAGE(PG8_SA(0, 1), cA + hstep, voffA);
        if (wr == 1) PG8_BAR;
        PG8_WAIT_V(2); PG8_BAR;
        PG8_STAGE(PG8_SB(1, 0), cB + kstep, voffB); PG8_STAGE(PG8_SA(1, 0), cA + kstep, voffA); PG8_STAGE(PG8_SB(1, 1), cB + hstep + kstep, voffB);
        PG8_WAIT_V(6); PG8_BAR;
    } else {
        PG8_STAGE(PG8_SB(0, 0), cB, voffB); PG8_STAGE(PG8_SA(0, 0), cA, voffA); PG8_STAGE(PG8_SB(0, 1), cB + hstep, voffB); PG8_STAGE(PG8_SA(0, 1), cA + hstep, voffA);
        if (wr == 1) PG8_BAR;
        PG8_WAIT_V(4); PG8_BAR;
        PG8_STAGE(PG8_SB(1, 0), cB + kstep, voffB); PG8_STAGE(PG8_SA(1, 0), cA + kstep, voffA); PG8_STAGE(PG8_SB(1, 1), cB + hstep + kstep, voffB);
        PG8_WAIT_V(6); PG8_BAR;
    }
    for (;;) {
        const bool has_next = S.next(ui + 1, nxt);
        const char* nA = has_next ? (const char*)g.A + (size_t)nxt.pm * tstep : cA; const char* nB = has_next ? (const char*)g.Bt + (size_t)nxt.pn * tstep : cB;
        for (int t = 0; t < nt; t += 2) {
            const bool last = (t == nt - 2);
            const char* a1 = cA + (size_t)(t + 1) * kstep;
            const char* a2 = last ? nA : cA + (size_t)(t + 2) * kstep; const char* b2 = last ? nB : cB + (size_t)(t + 2) * kstep;
            const char* a3 = a2 + kstep; const char* b3 = b2 + kstep;
            if (last && has_next) S.a_ready(nxt);
            if constexpr (SP2) {
            PG8_LDB(B0, 0, 0); PG8_LDB(B1, 0, 1); PG8_SCHED; PG8_LDA(At, 0, 0); PG8_STAGE(PG8_SA(1, 1), a1 + hstep, voffA);
            PG8_WAIT_V(8); PG8_WAIT_L(0); PG8_BAR; PG8_MMA(0, 0, At, B0); PG8_MMA(0, 1, At, B1); PG8_BAR; PG8_SCHED;
            PG8_LDA(At, 0, 1); PG8_STAGE(PG8_SB(0, 0), b2, voffB); PG8_STAGE(PG8_SB(0, 1), b2 + hstep, voffB); PG8_STAGE(PG8_SA(0, 0), a2, voffA);
            PG8_WAIT_V(8); PG8_WAIT_L(0); PG8_BAR; PG8_MMA(1, 0, At, B0); PG8_MMA(1, 1, At, B1); PG8_BAR; PG8_SCHED;
            PG8_LDB(B0, 1, 0); PG8_LDB(B1, 1, 1); PG8_SCHED; PG8_LDA(At, 1, 0); PG8_STAGE(PG8_SA(0, 1), a2 + hstep, voffA);
            PG8_WAIT_V(8); PG8_WAIT_L(0); PG8_BAR; PG8_MMA(0, 0, At, B0); PG8_MMA(0, 1, At, B1); PG8_BAR; PG8_SCHED;
            PG8_LDA(At, 1, 1); PG8_STAGE(PG8_SB(1, 0), b3, voffB); PG8_STAGE(PG8_SB(1, 1), b3 + hstep, voffB); PG8_STAGE(PG8_SA(1, 0), a3, voffA);
            PG8_WAIT_V(8); PG8_WAIT_L(0); PG8_BAR; PG8_MMA(1, 0, At, B0); PG8_MMA(1, 1, At, B1); PG8_BAR; PG8_SCHED;
            } else {
            PG8_LDB(B0, 0, 0); PG8_SCHED; PG8_LDA(At, 0, 0); PG8_STAGE(PG8_SA(1, 1), a1 + hstep, voffA);
            PG8_WAIT_L(8); PG8_BAR; PG8_WAIT_L(0); PG8_MMA(0, 0, At, B0); PG8_BAR; PG8_SCHED;
            PG8_LDB(B1, 0, 1); PG8_STAGE(PG8_SB(0, 0), b2, voffB);
            PG8_BAR; PG8_WAIT_L(0); PG8_MMA(0, 1, At, B1); PG8_BAR;
            PG8_LDA(At, 0, 1); PG8_STAGE(PG8_SA(0, 0), a2, voffA);
            PG8_BAR; PG8_WAIT_L(0); PG8_MMA(1, 0, At, B0); PG8_BAR; PG8_SCHED;
            PG8_STAGE(PG8_SB(0, 1), b2 + hstep, voffB);
            PG8_WAIT_V(6); PG8_BAR; PG8_MMA(1, 1, At, B1); PG8_BAR;
            PG8_LDB(B0, 1, 0); PG8_SCHED; PG8_LDA(At, 1, 0); PG8_STAGE(PG8_SA(0, 1), a2 + hstep, voffA);
            PG8_WAIT_L(8); PG8_BAR; PG8_WAIT_L(0); PG8_MMA(0, 0, At, B0); PG8_BAR; PG8_SCHED;
            PG8_LDB(B1, 1, 1); PG8_STAGE(PG8_SB(1, 0), b3, voffB);
            PG8_BAR; PG8_WAIT_L(0); PG8_MMA(0, 1, At, B1); PG8_BAR;
            PG8_LDA(At, 1, 1); PG8_STAGE(PG8_SA(1, 0), a3, voffA);
            PG8_BAR; PG8_WAIT_L(0); PG8_MMA(1, 0, At, B0); PG8_BAR; PG8_SCHED;
            PG8_STAGE(PG8_SB(1, 1), b3 + hstep, voffB);
            PG8_WAIT_V(6); PG8_BAR; PG8_MMA(1, 1, At, B1); PG8_BAR;
            }
        }
        if constexpr (ALIGN_EPI) { if (wr == 0) PG8_BAR; }
        if constexpr (!Epi::AFTER_DRAIN) { E(acc, cur, wr, wc, fr, fq); S.done(cur); }
        if (!has_next) break;
#pragma unroll
        for (int a = 0; a < 2; ++a)
#pragma unroll
            for (int b = 0; b < 2; ++b)
#pragma unroll
                for (int m = 0; m < 4; ++m)
#pragma unroll
                    for (int n = 0; n < 2; ++n) acc[a][b][m][n] = (f32x4){0.f, 0.f, 0.f, 0.f};
        cur = nxt; cA = nA; cB = nB; ++ui;
        if constexpr (ALIGN_EPI) { if (wr == 1) PG8_BAR; }
    }
    PG8_WAIT_V(0);
    if constexpr (!ALIGN_EPI) { if (wr == 0) PG8_BAR; }
    PG8_BAR;
    if constexpr (Epi::AFTER_DRAIN) { E.fused(acc, cur, wr, wc, fr, fq, lds, wid, lane); S.done(cur); }
#undef PG8_SA
#undef PG8_SB
#undef PG8_STAGE
#undef PG8_LDA
#undef PG8_LDB
#undef PG8_MMA
#undef PG8_WAIT_V
#undef PG8_WAIT_L
#undef PG8_BAR
#undef PG8_SCHED
}
}
#define GAS __attribute__((address_space(1)))
#define LAS __attribute__((address_space(3)))
typedef unsigned short bf16;
typedef unsigned v4u __attribute__((ext_vector_type(4)));
typedef float f32x4 __attribute__((ext_vector_type(4)));
typedef short bf16x8 __attribute__((ext_vector_type(8)));
typedef GAS unsigned gu32;
typedef GAS unsigned long long gu64;
#define RLX_AGENT __ATOMIC_RELAXED, __HIP_MEMORY_SCOPE_AGENT
#define LDS_WAIT() asm volatile("s_waitcnt lgkmcnt(0)" ::: "memory")
#define VM_WAIT() asm volatile("s_waitcnt vmcnt(0)" ::: "memory")
__device__ __forceinline__ unsigned long long rt() { return __builtin_amdgcn_s_memrealtime(); }
__device__ __forceinline__ unsigned f2bf(float f) { unsigned u = __builtin_bit_cast(unsigned, f); return (u + 0x7fffu + ((u >> 16) & 1u)) >> 16; }
__device__ __forceinline__ unsigned pk2(float lo, float hi) { return f2bf(lo) | (f2bf(hi) << 16); }

#define XB_TMO      128
#define XB_XCNT(j)  (256  + 64 * (j))
#define XB_XSUB(j)  (1280 + 64 * (j))
#define XB_XGEN(j)  (2304 + 64 * (j))
#define XB_TOP      3328
#define XB_TOPGEN   3392
#define XCD_BAR_WORDS 3456
#define XB_SPIN_CAP (1u << 21)

__device__ __forceinline__ unsigned xb_ld(unsigned* p)              { return __hip_atomic_load(p, __ATOMIC_RELAXED, __HIP_MEMORY_SCOPE_AGENT); }
__device__ __forceinline__ unsigned xb_add(unsigned* p, unsigned v) { return __hip_atomic_fetch_add(p, v, __ATOMIC_RELAXED, __HIP_MEMORY_SCOPE_AGENT); }
__device__ __forceinline__ unsigned xb_xcc_id() { return (unsigned)__builtin_amdgcn_s_getreg((3 << 11) | 20) & 0xFu; }
#define XB_SPIN(cond, bar) do { unsigned _sp = 0; while (cond) { __builtin_amdgcn_s_sleep(1); \
    if ((++_sp & 255u) == 0u) { if (xb_ld(&(bar)[XB_TMO])) break; if (_sp > XB_SPIN_CAP) { atomicAdd(&(bar)[XB_TMO], 1u); break; } } } } while (0)

struct XcdBarrier {
    unsigned* bar; unsigned x;
    volatile LAS unsigned* st;
};

__device__ __forceinline__ XcdBarrier xcd_barrier_post(unsigned* bar, volatile LAS unsigned* st) {
    XcdBarrier b; b.bar = bar; b.x = xb_xcc_id(); b.st = st;
    if (threadIdx.x == 0) (void)xb_add(&bar[XB_XCNT(b.x)], 1u);
    return b;
}
__device__ __forceinline__ void xcd_barrier_complete(unsigned* bar, unsigned x, unsigned& nloc, unsigned& nx) {
    const unsigned G = gridDim.x * gridDim.y * gridDim.z;
    unsigned sum, cnt, mine, sp = 0u;
    for (;;) {
        sum = 0u; cnt = 0u; mine = 0u;
#pragma unroll
        for (unsigned j = 0; j < 16; ++j) { const unsigned c = xb_ld(&bar[XB_XCNT(j)]); sum += c; cnt += (c > 0u) ? 1u : 0u; mine = (j == x) ? c : mine; }
        if (sum == G) break;
        __builtin_amdgcn_s_sleep(1);
        if ((++sp & 255u) == 0u) { if (xb_ld(&bar[XB_TMO])) break; if (sp > XB_SPIN_CAP) { atomicAdd(&bar[XB_TMO], 1u); break; } }
    }
    nloc = mine > 0u ? mine : 1u; nx = cnt > 0u ? cnt : 1u;
}

__device__ __forceinline__ void xcd_barrier(const XcdBarrier& b, const bool is_t0  ) {
    asm volatile("s_waitcnt vmcnt(0)" ::: "memory");
    __syncthreads();
    if (is_t0) {
        unsigned* bar = b.bar;
        __builtin_amdgcn_s_waitcnt(0);
        unsigned nloc = b.st[0], nx = b.st[1];
        if (nloc == 0u) { xcd_barrier_complete(bar, b.x, nloc, nx); b.st[0] = nloc; b.st[1] = nx; }
        const unsigned old = xb_add(&bar[XB_XSUB(b.x)], 1u);
        const unsigned gen = old / nloc;
        if (old + 1u == (gen + 1u) * nloc) {
            __builtin_amdgcn_fence(__ATOMIC_RELEASE, "agent");
            asm volatile("s_waitcnt vmcnt(0)" ::: "memory");
            const unsigned og = xb_add(&bar[XB_TOP], 1u);
            const unsigned tg = og / nx;
            if (og + 1u == (tg + 1u) * nx) xb_add(&bar[XB_TOPGEN], 1u);
            else XB_SPIN(xb_ld(&bar[XB_TOPGEN]) == tg, bar);
            __builtin_amdgcn_fence(__ATOMIC_ACQUIRE, "agent");
            xb_add(&bar[XB_XGEN(b.x)], 1u);
            asm volatile("s_waitcnt vmcnt(0)" ::: "memory");
        } else {
            XB_SPIN(xb_ld(&bar[XB_XGEN(b.x)]) == gen, bar);
            __builtin_amdgcn_fence(__ATOMIC_ACQUIRE, "agent");
            asm volatile("s_waitcnt vmcnt(0)" ::: "memory");
        }
    }
    __syncthreads();
}

namespace moba {
using bf16x8 = __attribute__((ext_vector_type(8))) short;
using s16x4  = __attribute__((ext_vector_type(4))) short;
using f32x16 = __attribute__((ext_vector_type(16))) float;
using u32x4  = __attribute__((ext_vector_type(4))) unsigned;
typedef unsigned short bf16;
constexpr int KVBLK = 64, LDK = 1024, NT = 4;
constexpr int SHM_V = KVBLK * 128 * 2, SHM_K = SHM_V;
constexpr int OFF_WS = 2 * SHM_V + 2 * SHM_K, OFF_RO = OFF_WS + 8 * 64 * 4, LDS_ATTN = OFF_RO + 8 * 32 * 4;
constexpr float THR2 = 11.5f;
#define KSWZ(row, colB) ((row) * 256 + ((colB) ^ (((row) & 7) << 4)))
#define SBAR() __builtin_amdgcn_sched_barrier(0)
__device__ __forceinline__ int crow(int r, int hi) { return (r & 3) + 8 * (r >> 2) + 4 * hi; }
__device__ __forceinline__ unsigned cvtpk(float lo, float hi) { unsigned r; asm volatile("v_cvt_pk_bf16_f32 %0, %1, %2" : "=v"(r) : "v"(lo), "v"(hi)); return r; }

__device__ __forceinline__ void partialSM(f32x16& p0, f32x16& p1, float& m_reg, float& mn, float& alpha) {
  float pmax = p0[0];
#pragma unroll
  for (int r = 1; r < 16; ++r) pmax = fmaxf(pmax, p0[r]);
#pragma unroll
  for (int r = 0; r < 16; ++r) pmax = fmaxf(pmax, p1[r]);
  { auto rr = __builtin_amdgcn_permlane32_swap(__float_as_uint(pmax), __float_as_uint(pmax), false, false);
    pmax = fmaxf(__uint_as_float(rr[0]), __uint_as_float(rr[1])); }
  if (__builtin_expect(__all(pmax - m_reg <= THR2), 1)) { mn = m_reg; alpha = 1.f; }
  else { mn = fmaxf(m_reg, pmax); alpha = __builtin_amdgcn_exp2f(m_reg - mn); m_reg = mn; }
#pragma unroll
  for (int r = 0; r < 16; ++r) { p0[r] = p0[r] - mn; p1[r] = p1[r] - mn; }
#pragma unroll
  for (int r = 0; r < 16; ++r) p0[r] = __builtin_amdgcn_exp2f(p0[r]);
}
__device__ __forceinline__ void finishSM(f32x16& p0, f32x16& p1, float alpha, float& l_reg, bf16x8& pa0, bf16x8& pa1, bf16x8& pa2, bf16x8& pa3) {
#pragma unroll
  for (int r = 0; r < 16; ++r) p1[r] = __builtin_amdgcn_exp2f(p1[r]);
  float ps = 0;
#pragma unroll
  for (int r = 0; r < 16; ++r) ps += p0[r];
#pragma unroll
  for (int r = 0; r < 16; ++r) ps += p1[r];
  { auto rr = __builtin_amdgcn_permlane32_swap(__float_as_uint(ps), __float_as_uint(ps), false, false);
    ps = __uint_as_float(rr[0]) + __uint_as_float(rr[1]); }
  l_reg = l_reg * alpha + ps;
#define PK4(P, BASE, OUT) do { unsigned a0 = cvtpk(P[BASE + 0], P[BASE + 1]), a1 = cvtpk(P[BASE + 2], P[BASE + 3]);   \
    unsigned b0 = cvtpk(P[BASE + 4], P[BASE + 5]), b1 = cvtpk(P[BASE + 6], P[BASE + 7]);                              \
    auto r0 = __builtin_amdgcn_permlane32_swap(a0, b0, false, false); auto r1 = __builtin_amdgcn_permlane32_swap(a1, b1, false, false); \
    u32x4 w = {r0[0], r1[0], r0[1], r1[1]}; OUT = *reinterpret_cast<bf16x8*>(&w); } while (0)
  PK4(p0, 0, pa0); PK4(p0, 8, pa1); PK4(p1, 0, pa2); PK4(p1, 8, pa3);
#undef PK4
}
__device__ __forceinline__ void qkt(f32x16& p0, f32x16& p1, const char* Ks, const bf16x8* qr, int r32, int hi) {
  p0 = f32x16{}; p1 = f32x16{};
#pragma unroll
  for (int d0 = 0; d0 < 8; ++d0) { int cb = (d0 * 16 + hi * 8) * 2;
    bf16x8 b0 = *reinterpret_cast<const bf16x8*>(Ks + KSWZ(r32, cb));
    bf16x8 b1 = *reinterpret_cast<const bf16x8*>(Ks + KSWZ(32 + r32, cb));
    p0 = __builtin_amdgcn_mfma_f32_32x32x16_bf16(b0, qr[d0], p0, 0, 0, 0);
    p1 = __builtin_amdgcn_mfma_f32_32x32x16_bf16(b1, qr[d0], p1, 0, 0, 0); }
}
__device__ __forceinline__ void bias_mask(f32x16& p0, f32x16& p1, float tb, float sl2, int lim) {
#pragma unroll
  for (int r = 0; r < 16; ++r) { const int c = (r & 3) + 8 * (r >> 2);
    p0[r] += fmaf(sl2, (float)c, tb); p1[r] += fmaf(sl2, (float)(c + 32), tb);
    if (c > lim) p0[r] = -INFINITY; if (c + 32 > lim) p1[r] = -INFINITY; }
}
__device__ __forceinline__ int v_st(int k, int c) { const int kk = (k & ~0xC) | ((k & 4) << 1) | ((k & 8) >> 1); return ((kk >> 3) * 4 + (c >> 5)) * 512 + ((kk & 7) * 32 + (c & 31)) * 2; }
__device__ __forceinline__ int v_rd_base(int lane) { return ((lane & 3) << 3) | (((lane >> 2) & 3) << 6) | (((lane >> 4) & 1) << 5) | (((lane >> 5) & 1) << 8); }
constexpr int v_rd_off(int d0, int ks, int half) { return d0 * 512 + ks * 4096 + half * 2048; }
template <int OFF> __device__ __forceinline__ s16x4 tr_read(int vb) {
  s16x4 r; asm volatile("ds_read_b64_tr_b16 %0, %1 offset:%2" : "=&v"(r) : "v"(vb), "i"(OFF) : "memory"); return r;
}
template <int D0> __device__ __forceinline__ void pv_one(f32x16& od, int vb, bf16x8 pa0, bf16x8 pa1, bf16x8 pa2, bf16x8 pa3) {
  const s16x4 l0 = tr_read<v_rd_off(D0, 0, 0)>(vb), h0 = tr_read<v_rd_off(D0, 0, 1)>(vb), l1 = tr_read<v_rd_off(D0, 1, 0)>(vb), h1 = tr_read<v_rd_off(D0, 1, 1)>(vb);
  const s16x4 l2 = tr_read<v_rd_off(D0, 2, 0)>(vb), h2 = tr_read<v_rd_off(D0, 2, 1)>(vb), l3 = tr_read<v_rd_off(D0, 3, 0)>(vb), h3 = tr_read<v_rd_off(D0, 3, 1)>(vb);
  asm volatile("s_waitcnt lgkmcnt(0)" ::: "memory"); SBAR();
#define PK(L, H) (bf16x8){L[0], L[1], L[2], L[3], H[0], H[1], H[2], H[3]}
  od = __builtin_amdgcn_mfma_f32_32x32x16_bf16(pa0, PK(l0, h0), od, 0, 0, 0);
  od = __builtin_amdgcn_mfma_f32_32x32x16_bf16(pa1, PK(l1, h1), od, 0, 0, 0);
  od = __builtin_amdgcn_mfma_f32_32x32x16_bf16(pa2, PK(l2, h2), od, 0, 0, 0);
  od = __builtin_amdgcn_mfma_f32_32x32x16_bf16(pa3, PK(l3, h3), od, 0, 0, 0);
#undef PK
}
__device__ __forceinline__ void pv_d0(f32x16* o, int vb, bf16x8 pa0, bf16x8 pa1, bf16x8 pa2, bf16x8 pa3) {
  pv_one<0>(o[0], vb, pa0, pa1, pa2, pa3); pv_one<1>(o[1], vb, pa0, pa1, pa2, pa3); pv_one<2>(o[2], vb, pa0, pa1, pa2, pa3); pv_one<3>(o[3], vb, pa0, pa1, pa2, pa3);
}

__device__ __forceinline__ void attn_unit(const bf16* Qw, const bf16* Kh, const bf16* Vh, float lsecorr, int qlim, float sl2, bool valid, unsigned outoff, bf16* obase, float* lse, char* lds, int tid) {
  const int wid = tid >> 6, lane = tid & 63, r32 = lane & 31, hi = lane >> 5;
  char* V_lds = lds; char* K_lds = lds + 2 * SHM_V;
  float* wsf = (float*)(lds + OFF_WS) + wid * 64; float* li_l = wsf; float* al_l = wsf + 32; unsigned* ro_l = (unsigned*)(lds + OFF_RO) + wid * 32;
  float m_reg = -1e30f, l_reg = 0; f32x16 o[4] = {}; bf16x8 qr[8];
#pragma unroll
  for (int d0 = 0; d0 < 8; ++d0) qr[d0] = *reinterpret_cast<const bf16x8*>(Qw + d0 * 16);
  const int sr = tid >> 4, sc = (tid & 15) * 8, vst0 = v_st(sr, sc), vst1 = v_st(32 + sr, sc);
  const int vb0 = (int)(uintptr_t)V_lds + v_rd_base(lane);
  bf16x8 vs0, vs1, ks0, ks1;
#define SLOAD(k0) do { vs0 = *reinterpret_cast<const bf16x8*>(&Vh[(long)((k0) + sr) * LDK + sc]); vs1 = *reinterpret_cast<const bf16x8*>(&Vh[(long)((k0) + 32 + sr) * LDK + sc]); \
    ks0 = *reinterpret_cast<const bf16x8*>(&Kh[(long)((k0) + sr) * LDK + sc]); ks1 = *reinterpret_cast<const bf16x8*>(&Kh[(long)((k0) + 32 + sr) * LDK + sc]); } while (0)
#define SWRITE(b) do { *(bf16x8*)(V_lds + (b) * SHM_V + vst0) = vs0; *(bf16x8*)(V_lds + (b) * SHM_V + vst1) = vs1; const int kc = sc * 2; \
    *(bf16x8*)(K_lds + (b) * SHM_K + KSWZ(sr, kc)) = ks0; *(bf16x8*)(K_lds + (b) * SHM_K + KSWZ(32 + sr, kc)) = ks1; } while (0)
  const float tb0 = sl2 * (float)(4 * hi), tstep = sl2 * 64.f; const int lim0 = qlim - 4 * hi;
  SLOAD(0); SWRITE(0); __syncthreads();
#pragma unroll
  for (int t = 0; t < NT; ++t) {
    if (t + 1 < NT) SLOAD((t + 1) * KVBLK);
    f32x16 p0, p1; float mn, alpha; bf16x8 pa0, pa1, pa2, pa3;
    qkt(p0, p1, K_lds + (t & 1) * SHM_K, qr, r32, hi);
    bias_mask(p0, p1, tb0 + tstep * (float)t, sl2, lim0 - 64 * t);
    partialSM(p0, p1, m_reg, mn, alpha);
    finishSM(p0, p1, alpha, l_reg, pa0, pa1, pa2, pa3);
    if (__any(alpha < 1.f)) { if (hi == 0) al_l[r32] = alpha; asm volatile("s_waitcnt lgkmcnt(0)" ::: "memory");
#pragma unroll
      for (int d = 0; d < 4; ++d)
#pragma unroll
        for (int r = 0; r < 16; ++r) o[d][r] *= al_l[crow(r, hi)]; }
    SBAR();
    pv_d0(o, vb0 + (t & 1) * SHM_V, pa0, pa1, pa2, pa3);
    if (t + 1 < NT) { SWRITE((t + 1) & 1); __syncthreads(); }
  }
  if (hi == 0) { li_l[r32] = l_reg; ro_l[r32] = valid ? outoff : 0xffffffffu; if (valid) *lse = m_reg + __builtin_amdgcn_logf(l_reg) + lsecorr; }
  asm volatile("s_waitcnt lgkmcnt(0)" ::: "memory");
#pragma unroll
  for (int r = 0; r < 16; ++r) { const int orow = crow(r, hi); const float rl = __builtin_amdgcn_rcpf(li_l[orow]); const unsigned off = ro_l[orow];
    if (off != 0xffffffffu) {
#pragma unroll
      for (int d0 = 0; d0 < 4; ++d0) obase[(size_t)off + d0 * 32 + r32] = (bf16)(cvtpk(o[d0][r] * rl, 0.f) & 0xffffu); } }
  __syncthreads();
#undef SLOAD
#undef SWRITE
}
#undef KSWZ
#undef SBAR
}

constexpr int NWAVES = 8, NTHR = NWAVES * 64;
constexpr int BATCH = 2, T = 8192, D = 1024, M = BATCH * T, FF = 4096;
constexpr int NH = 8, DH = 128, BLK = 256, NBLK = T / BLK;
constexpr int LH = 8, DQK = 64, DV = 128, LC = 64, NCH = T / LC;
constexpr int NIN = 2 * LH * DQK + 2 * LH * DV + 2 * LH;
constexpr int NIN_G = 3072;
constexpr float RMS_EPS = 1e-6f, SOFTCAP = 15.0f;
constexpr float LOG2E = 1.4426950408889634f;
constexpr float QSCALE = 0.08838834764831845f * LOG2E;
constexpr float NEG_BIG = -1e30f;

constexpr size_t MiB = 1u << 20;
constexpr size_t WS_CTL = 0, CTL_ZERO_BYTES = 1 * MiB;
constexpr size_t WS_USUM = 1 * MiB;
constexpr size_t WS_KMEAN = 2 * MiB;
constexpr size_t WS_G = 3 * MiB;
constexpr size_t WS_MASK = 5 * MiB;
constexpr size_t WS_LIST = 1 * MiB;
constexpr size_t WS_CNT = 5 * MiB + 512 * 1024;
constexpr size_t WS_LSE = 6 * MiB;
constexpr size_t WS_PSEL = 160 * MiB;
constexpr size_t WS_GIF = 6 * MiB;
constexpr size_t WS_SMALL = 7 * MiB;
constexpr size_t WS_W = 8 * MiB;
constexpr size_t WS_XN = 32 * MiB;
constexpr size_t WS_QKV = 64 * MiB;
constexpr size_t WS_DC = 160 * MiB;
constexpr size_t WS_U = 192 * MiB;
constexpr size_t WS_END = 256 * MiB;
constexpr int CW_BAR = 4096;

constexpr int RING_BYTES = 131072;
constexpr int LDSCTL_OFF = RING_BYTES, MISC_OFF = LDSCTL_OFF + 320;
constexpr int LDS_BYTES = 147456;

__device__ __forceinline__ float bperm_f(int srclane, float v) { return __int_as_float(__builtin_amdgcn_ds_bpermute(srclane << 2, __float_as_int(v))); }
__device__ __forceinline__ int bperm_i(int srclane, int v) { return __builtin_amdgcn_ds_bpermute(srclane << 2, v); }
__device__ __forceinline__ float rdlane_f(float v, int l) { return __int_as_float(__builtin_amdgcn_readlane(__float_as_int(v), l)); }
__device__ __forceinline__ float wave_sum(float v, int lane) {
#pragma unroll
    for (int o = 1; o < 64; o <<= 1) v += bperm_f(lane ^ o, v);
    return v;
}
__device__ __forceinline__ float wave_max(float v, int lane) {
#pragma unroll
    for (int o = 1; o < 64; o <<= 1) v = fmaxf(v, bperm_f(lane ^ o, v));
    return v;
}
__device__ __forceinline__ float bf_lo(unsigned w) { return __uint_as_float(w << 16); }
__device__ __forceinline__ float bf_hi(unsigned w) { return __uint_as_float(w & 0xffff0000u); }
__device__ __forceinline__ float bf1(bf16 h) { return __uint_as_float(((unsigned)h) << 16); }

__device__ __forceinline__ void transpose_item(const float* W, int K, int N, int ld, bf16* WT, LAS float* scr, int item, int lane) {
    const int nblk = N / 32, kb = item / nblk, nb = item % nblk, k0 = 64 * kb, n0 = 32 * nb;
#pragma unroll 8
    for (int i = 0; i < 32; ++i) { const int kk = 2 * i + (lane >> 5); scr[kk * 33 + (lane & 31)] = W[(size_t)(k0 + kk) * ld + n0 + (lane & 31)]; }
    LDS_WAIT(); asm volatile("" ::: "memory");
    const int c = lane & 7;
#pragma unroll
    for (int j = 0; j < 4; ++j) { const int n = (lane >> 3) + 8 * j; const LAS float* s = scr + (8 * c) * 33 + n;
        v4u o; o.x = pk2(s[0 * 33], s[1 * 33]); o.y = pk2(s[2 * 33], s[3 * 33]); o.z = pk2(s[4 * 33], s[5 * 33]); o.w = pk2(s[6 * 33], s[7 * 33]);
        *(GAS v4u*)(WT + (size_t)(n0 + n) * K + k0 + 8 * c) = o; }
    LDS_WAIT(); asm volatile("" ::: "memory");
}
__device__ __forceinline__ void convert_weights(const float* wmix_in, int ld_in, const float* wmix_out, const float* wup, const float* wdown, unsigned char* ws, LAS unsigned char* lds, int gw, int NGW, int wave, int lane) {
    LAS float* scr = (LAS float*)(lds + wave * 16384);
    bf16* W_IN = (bf16*)(ws + WS_W); bf16* W_OUT = (bf16*)(ws + WS_W + 6 * MiB); bf16* W_UP = (bf16*)(ws + WS_W + 8 * MiB); bf16* W_DN = (bf16*)(ws + WS_W + 16 * MiB);
    constexpr int I_IN = (D / 64) * (3072 / 32), I_O = (D / 64) * (D / 32), I_UP = (D / 64) * (FF / 32), I_DN = (FF / 64) * (D / 32);
    for (int it = gw; it < I_IN + I_O + I_UP + I_DN; it += NGW) {
        int r = it;
        if (r < I_IN) { transpose_item(wmix_in, D, 3072, ld_in, W_IN, scr, r, lane); continue; } r -= I_IN;
        if (r < I_O) { transpose_item(wmix_out, D, D, D, W_OUT, scr, r, lane); continue; } r -= I_O;
        if (r < I_UP) { transpose_item(wup, D, FF, FF, W_UP, scr, r, lane); continue; } r -= I_UP;
        transpose_item(wdown, FF, D, D, W_DN, scr, r, lane);
    }
}

__device__ __forceinline__ void rms_row(const float* xrow, const float* gain, int lane, f32x4 (&u)[4]) {
    const GAS f32x4* xr = (const GAS f32x4*)xrow + lane; const GAS f32x4* gr = (const GAS f32x4*)gain + lane;
    float s = 0.f;
#pragma unroll
    for (int j = 0; j < 4; ++j) { u[j] = xr[64 * j]; s += (u[j].x * u[j].x + u[j].y * u[j].y) + (u[j].z * u[j].z + u[j].w * u[j].w); }
    const float r = 1.0f / sqrtf(wave_sum(s, lane) * (1.f / D) + RMS_EPS);
#pragma unroll
    for (int j = 0; j < 4; ++j) { const f32x4 g = gr[64 * j]; u[j] = u[j] * r * g; }
}
__device__ __forceinline__ void store_row_bf16(bf16* orow, int lane, const f32x4 (&u)[4]) {
    GAS unsigned long long* o8 = (GAS unsigned long long*)orow + lane;
#pragma unroll
    for (int j = 0; j < 4; ++j) o8[64 * j] = (unsigned long long)pk2(u[j].x, u[j].y) | ((unsigned long long)pk2(u[j].z, u[j].w) << 32);
}

__device__ __forceinline__ void phase_p0(const float* x, const float* gain, unsigned char* ws, LAS unsigned char* lds, int wg, int G, int tid, int wave, int lane) {
    bf16* XN = (bf16*)(ws + WS_XN); float* USUM = (float*)(ws + WS_USUM);
    LAS f32x4* red = (LAS f32x4*)lds;
    for (int part = wg; part < M / 64; part += G) {
        f32x4 acc[4];
#pragma unroll
        for (int j = 0; j < 4; ++j) acc[j] = (f32x4){0.f, 0.f, 0.f, 0.f};
        for (int i = 0; i < 8; ++i) {
            const int row = part * 64 + wave * 8 + i; f32x4 u[4];
            rms_row(x + (size_t)row * D, gain, lane, u);
            store_row_bf16(XN + (size_t)row * D, lane, u);
#pragma unroll
            for (int j = 0; j < 4; ++j) acc[j] = acc[j] + u[j];
        }
#pragma unroll
        for (int j = 0; j < 4; ++j) red[wave * 256 + 64 * j + lane] = acc[j];
        __syncthreads();
        if (tid < 256) { f32x4 s = red[tid];
#pragma unroll
            for (int w = 1; w < 8; ++w) s = s + red[w * 256 + tid];
            *((GAS f32x4*)(USUM + (size_t)part * 1024) + tid) = s; }
        __syncthreads();
    }
}
__device__ __forceinline__ void phase_kmean(const float* wqkv, unsigned char* ws, int wg, int G, int wave, int lane) {
    const float* USUM = (const float*)(ws + WS_USUM); float* KMEAN = (float*)(ws + WS_KMEAN);
    for (int cg = wg; cg < 256; cg += G) {
        f32x4 w[16];
#pragma unroll
        for (int kk = 0; kk < 16; ++kk) w[kk] = *(const GAS f32x4*)(wqkv + (size_t)(64 * kk + lane) * 3072 + 1024 + 4 * cg);
        for (int bl = 0; bl < 8; ++bl) {
            const int blk = wave * 8 + bl; f32x4 a = (f32x4){0.f, 0.f, 0.f, 0.f};
#pragma unroll
            for (int kk = 0; kk < 16; ++kk) { const int k = 64 * kk + lane; const float* up = USUM + (size_t)(4 * blk) * 1024 + k;
                const float us = (up[0] + up[1024]) + (up[2048] + up[3072]); a = a + w[kk] * us; }
            a.x = wave_sum(a.x, lane); a.y = wave_sum(a.y, lane); a.z = wave_sum(a.z, lane); a.w = wave_sum(a.w, lane);
            if (lane == 0) *(GAS f32x4*)(KMEAN + (size_t)blk * 1024 + 4 * cg) = a * (1.0f / 256.0f);
        }
    }
}
__device__ __forceinline__ void phase_g(const float* wqkv, unsigned char* ws, int wg, int G, int wave, int lane) {
    const float* KMEAN = (const float*)(ws + WS_KMEAN); float* GM = (float*)(ws + WS_G);
    for (int unit = wg; unit < 256; unit += G) {
        const int h = unit & 7, kg = (unit >> 3) & 15, bh = unit >> 7, k = 64 * kg + lane;
        const float* wq = wqkv + (size_t)k * 3072 + h * 128;
        float acc[4] = {0.f, 0.f, 0.f, 0.f};
        for (int dc = 0; dc < 128; dc += 32) {
            f32x4 wv[8];
#pragma unroll
            for (int i = 0; i < 8; ++i) wv[i] = *(const GAS f32x4*)(wq + dc + 4 * i);
#pragma unroll
            for (int bl = 0; bl < 4; ++bl) { const int blk = bh * 32 + wave * 4 + bl; const float* km = KMEAN + (size_t)blk * 1024 + h * 128 + dc;
#pragma unroll
                for (int i = 0; i < 8; ++i) { const f32x4 kv = *(const GAS f32x4*)(km + 4 * i); acc[bl] += (wv[i].x * kv.x + wv[i].y * kv.y) + (wv[i].z * kv.z + wv[i].w * kv.w); } }
        }
#pragma unroll
        for (int bl = 0; bl < 4; ++bl) { const int blk = bh * 32 + wave * 4 + bl, b = blk >> 5, n = blk & 31; GM[((size_t)(b * 256 + h * 32 + n)) * 1024 + k] = acc[bl]; }
    }
}
__device__ __forceinline__ void phase_gate_naive(const float* x, const float* gain, unsigned char* ws, int gw, int NGW, int lane) {
    const float* GM = (const float*)(ws + WS_G); unsigned* MASK = (unsigned*)(ws + WS_MASK);
    for (int m = gw; m < M; m += NGW) {
        const int b = m >> 13, s = m & (T - 1), npast = s >> 8;
        if (npast == 0) { if (lane < 8) MASK[((size_t)(b * 8 + lane)) * T + s] = 0u; continue; }
        f32x4 u[4]; rms_row(x + (size_t)m * D, gain, lane, u);
        for (int h = 0; h < NH; ++h) {
            float v0 = -INFINITY, v1 = -INFINITY, v2 = -INFINITY; int i0 = 0, i1 = 0, i2 = 0;
            for (int n = 0; n < npast; ++n) {
                const GAS f32x4* gr = (const GAS f32x4*)(GM + ((size_t)(b * 256 + h * 32 + n)) * 1024) + lane; float a = 0.f;
#pragma unroll
                for (int j = 0; j < 4; ++j) { const f32x4 g = gr[64 * j]; a += (u[j].x * g.x + u[j].y * g.y) + (u[j].z * g.z + u[j].w * g.w); }
                a = wave_sum(a, lane);
                if (a > v0) { v2 = v1; i2 = i1; v1 = v0; i1 = i0; v0 = a; i0 = n; }
                else if (a > v1) { v2 = v1; i2 = i1; v1 = a; i1 = n; }
                else if (a > v2) { v2 = a; i2 = n; }
            }
            unsigned mk = 1u << i0; if (npast > 1) mk |= 1u << i1; if (npast > 2) mk |= 1u << i2;
            if (lane == 0) MASK[((size_t)(b * 8 + h)) * T + s] = mk;
        }
    }
}
__device__ __forceinline__ int list_base(int bh, int j) { return bh * 126976 + 256 * (31 * j - (j * (j - 1)) / 2); }
__device__ __forceinline__ void phase_lists(unsigned char* ws, int gw, int NGW, int lane) {
    const unsigned* MASKT = (const unsigned*)(ws + WS_MASK); unsigned short* LIST = (unsigned short*)(ws + WS_LIST); int* CNT = (int*)(ws + WS_CNT);
    for (int li = gw; li < 16 * 31; li += NGW) {
        const int bh = li / 31, j = li - bh * 31;
        const unsigned* mk = MASKT + (size_t)bh * T; unsigned short* dst = LIST + list_base(bh, j); int base = 0;
        for (int s0 = (j + 1) * BLK; s0 < T; s0 += 256) {
            const v4u m4 = *(const GAS v4u*)(mk + s0 + 4 * lane);
            const int f0 = (m4.x >> j) & 1, f1 = (m4.y >> j) & 1, f2 = (m4.z >> j) & 1, f3 = (m4.w >> j) & 1, c = f0 + f1 + f2 + f3;
            int inc = c;
#pragma unroll
            for (int o = 1; o < 64; o <<= 1) { const int t = bperm_i(lane - o, inc); if (lane >= o) inc += t; }
            int pos = base + inc - c; const int s = s0 + 4 * lane;
            if (f0) dst[pos++] = (unsigned short)s;
            if (f1) dst[pos++] = (unsigned short)(s + 1);
            if (f2) dst[pos++] = (unsigned short)(s + 2);
            if (f3) dst[pos++] = (unsigned short)(s + 3);
            base += __builtin_amdgcn_readlane(inc, 63);
        }
        if (lane == 0) CNT[li] = base;
    }
}
__device__ __forceinline__ void phase_attn(unsigned char* ws, char* lds, int wg, int G, int tid) {
    const bf16* Q = (const bf16*)(ws + WS_QKV); const bf16* K = Q + (size_t)M * D; const bf16* V = K + (size_t)M * D;
    const unsigned* MASKT = (const unsigned*)(ws + WS_MASK); const unsigned short* LIST = (const unsigned short*)(ws + WS_LIST); const int* CNT = (const int*)(ws + WS_CNT);
    bf16* POWN = (bf16*)(ws + WS_XN); bf16* PSEL = (bf16*)(ws + WS_PSEL); float* LSE = (float*)(ws + WS_LSE);
    int* pre = (int*)(lds + moba::LDS_ATTN);
    const int lane = tid & 63, wave = tid >> 6, r32 = lane & 31, hi = lane >> 5;
    {
        int c = (tid < 496) ? ((CNT[tid] + 255) >> 8) : 0;
#pragma unroll
        for (int o = 1; o < 64; o <<= 1) { const int t = bperm_i(lane - o, c); if (lane >= o) c += t; }
        int* wtot = pre + 512;
        if (lane == 63) wtot[wave] = c;
        __syncthreads();
        int add = 0;
#pragma unroll
        for (int w = 0; w < 8; ++w) if (w < wave) add += wtot[w];
        pre[tid] = c + add;
        __syncthreads();
    }
    const int total = __builtin_amdgcn_readfirstlane(512 + pre[495]);
    for (int u = wg; u < total; u += G) {
        int bh, jb, tile = 0, cnt = 256, own;
        if (u < 512) { bh = u >> 5; jb = u & 31; own = 1; }
        else {
            const int v = u - 512; int lo = 0, hi_ = 495;
            while (lo < hi_) { const int mid = (lo + hi_) >> 1; if (__builtin_amdgcn_readfirstlane(pre[mid]) > v) hi_ = mid; else lo = mid + 1; }
            const int li = lo; tile = v - (li ? __builtin_amdgcn_readfirstlane(pre[li - 1]) : 0); bh = li / 31; jb = li - bh * 31; own = 0;
            cnt = __builtin_amdgcn_readfirstlane(CNT[li]);
        }
        const int b = bh >> 3, h = bh & 7;
        const float sl2 = exp2f(-(float)(h + 1)) * LOG2E;
        const int idx = tile * 256 + wave * 32 + r32; const bool valid = idx < cnt;
        int sq, slot = 0;
        if (own) sq = jb * BLK + idx;
        else { sq = (int)LIST[list_base(bh, jb) + (valid ? idx : cnt - 1)]; slot = __builtin_popcount(MASKT[(size_t)bh * T + sq] & ((1u << jb) - 1u)); }
        const size_t m = (size_t)b * T + sq;
        const unsigned outoff = own ? (unsigned)(m * D + h * DH) : (unsigned)(((m * 8 + h) * 3 + slot) * DH);
        const size_t kv0 = ((size_t)b * T + jb * BLK) * D + h * DH;
        moba::attn_unit(Q + m * D + h * DH + hi * 8, K + kv0, V + kv0, -sl2 * (float)(sq - jb * BLK), own ? (wave * 32 + r32) : (1 << 20), sl2, valid, outoff, own ? POWN : PSEL,
                        LSE + (m * 8 + h) * 4 + (own ? 0 : 1 + slot), lds, tid);
    }
}
__device__ __forceinline__ void phase_combine(unsigned char* ws, int gtid, int NTH) {
    const unsigned* MASKT = (const unsigned*)(ws + WS_MASK); bf16* POWN = (bf16*)(ws + WS_XN); const bf16* PSEL = (const bf16*)(ws + WS_PSEL); const float* LSE = (const float*)(ws + WS_LSE);
    for (int e = gtid; e < M * NH * 16; e += NTH) {
        const int dg = e & 15, mh = e >> 4, h = mh & 7, m = mh >> 3, b = m >> 13, s = m & (T - 1);
        const int nsel = __builtin_popcount(MASKT[((size_t)(b * 8 + h)) * T + s]);
        const f32x4 l4 = *(const GAS f32x4*)(LSE + (size_t)mh * 4);
        float ls[4] = {l4.x, nsel > 0 ? l4.y : -INFINITY, nsel > 1 ? l4.z : -INFINITY, nsel > 2 ? l4.w : -INFINITY};
        const float mx = fmaxf(fmaxf(ls[0], ls[1]), fmaxf(ls[2], ls[3]));
        float w[4], den = 0.f;
#pragma unroll
        for (int p = 0; p < 4; ++p) { w[p] = exp2f(ls[p] - mx); den += w[p]; }
        const float inv = 1.0f / den;
        GAS v4u* own = (GAS v4u*)(POWN + (size_t)m * D + h * DH + dg * 8);
        float acc[8];
        { const v4u x = *own; const float ww = w[0] * inv;
          acc[0] = ww * bf_lo(x.x); acc[1] = ww * bf_hi(x.x); acc[2] = ww * bf_lo(x.y); acc[3] = ww * bf_hi(x.y); acc[4] = ww * bf_lo(x.z); acc[5] = ww * bf_hi(x.z); acc[6] = ww * bf_lo(x.w); acc[7] = ww * bf_hi(x.w); }
#pragma unroll
        for (int p = 1; p < 4; ++p) if (p <= nsel) { const v4u x = *(const GAS v4u*)(PSEL + ((size_t)mh * 3 + (p - 1)) * DH + dg * 8); const float ww = w[p] * inv;
          acc[0] += ww * bf_lo(x.x); acc[1] += ww * bf_hi(x.x); acc[2] += ww * bf_lo(x.y); acc[3] += ww * bf_hi(x.y); acc[4] += ww * bf_lo(x.z); acc[5] += ww * bf_hi(x.z); acc[6] += ww * bf_lo(x.w); acc[7] += ww * bf_hi(x.w); }
        v4u o; o.x = pk2(acc[0], acc[1]); o.y = pk2(acc[2], acc[3]); o.z = pk2(acc[4], acc[5]); o.w = pk2(acc[6], acc[7]);
        *own = o;
    }
}
template <bool SECOND, bool GATES>
__device__ __forceinline__ void norm_rows(const float* U, const float* hin, float* hout, const float* gpost, const float* gpre, bf16* XN, const LAS float* wg, const float* bg, float* GIF, int gw, int NGW, int lane) {
    for (int m = gw; m < M; m += NGW) {
        f32x4 u[4]; rms_row(U + (size_t)m * D, gpost, lane, u);
        const GAS f32x4* hr = (const GAS f32x4*)(hin + (size_t)m * D) + lane; GAS f32x4* ho = (GAS f32x4*)(hout + (size_t)m * D) + lane;
        float s = 0.f;
#pragma unroll
        for (int j = 0; j < 4; ++j) { u[j] = u[j] + hr[64 * j]; ho[64 * j] = u[j]; s += (u[j].x * u[j].x + u[j].y * u[j].y) + (u[j].z * u[j].z + u[j].w * u[j].w); }
        if (SECOND) {
            const float r = 1.0f / sqrtf(wave_sum(s, lane) * (1.f / D) + RMS_EPS); const GAS f32x4* gr = (const GAS f32x4*)gpre + lane;
#pragma unroll
            for (int j = 0; j < 4; ++j) u[j] = u[j] * r * gr[64 * j];
            store_row_bf16(XN + (size_t)m * D, lane, u);
            if (GATES) {
                float mine = 0.f;
#pragma unroll 1
                for (int g = 0; g < 16; ++g) { float a = 0.f;
#pragma unroll
                    for (int j = 0; j < 4; ++j) { const f32x4 w = *((const LAS f32x4*)(wg + g * 1024) + 64 * j + lane); a += (u[j].x * w.x + u[j].y * w.y) + (u[j].z * w.z + u[j].w * w.w); }
                    a = wave_sum(a, lane); if (lane == g) mine = a; }
                if (lane < 16) { const float z = SOFTCAP * tanhf((mine + bg[lane]) * (1.0f / SOFTCAP));
                    GIF[(size_t)m * 16 + lane] = (lane < 8) ? z : -log1pf(expf(-z)); }
            }
        }
    }
}
__device__ __forceinline__ float scan_add(float v, int lane) {
#pragma unroll
    for (int o = 1; o < 64; o <<= 1) { const float t = bperm_f(lane - o, v); if (lane >= o) v += t; }
    return v;
}
__device__ __forceinline__ float scan_max(float v, int lane) {
#pragma unroll
    for (int o = 1; o < 64; o <<= 1) { const float t = bperm_f(lane - o, v); if (lane >= o) v = fmaxf(v, t); }
    return v;
}
__device__ __forceinline__ void phase_mlstm_a(unsigned char* ws, int gw, int NGW, int lane) {
    const bf16* QK = (const bf16*)(ws + WS_QKV); const float* GIF = (const float*)(ws + WS_GIF);
    float* DC = (float*)(ws + WS_DC); float* BEND = (float*)(ws + WS_SMALL); float* MLOC = BEND + 2048; float* DN = BEND + 3 * 2048;
    float* BCUM = (float*)(ws + WS_USUM); float* GMX = BCUM + (size_t)M * 8;
    for (int unit = gw; unit < 16 * NCH; unit += NGW) {
        const int bh = unit >> 7, c = unit & 127, b = bh >> 3, h = bh & 7, tok0 = b * T + c * LC;
        const float lf = GIF[(size_t)(tok0 + lane) * 16 + 8 + h], li = GIF[(size_t)(tok0 + lane) * 16 + h];
        const float bc = scan_add(lf, lane), bend = rdlane_f(bc, 63), lw = bend - bc + li, mloc = wave_max(lw, lane), w = expf(lw - mloc);
        BCUM[(size_t)(tok0 + lane) * 8 + h] = bc; GMX[(size_t)(tok0 + lane) * 8 + h] = scan_max(li - bc, lane);
        float acc[128];
#pragma unroll
        for (int v = 0; v < 128; ++v) acc[v] = 0.f;
        float dn = 0.f;
#pragma unroll 1
        for (int s = 0; s < LC; ++s) {
            const float wsv = rdlane_f(w, s);
            const bf16* row = QK + (size_t)(tok0 + s) * NIN_G;
            const float kw = wsv * bf1(row[512 + h * DQK + lane]); dn += kw;
            const GAS v4u* vr = (const GAS v4u*)(row + 1024 + h * DV);
#pragma unroll
            for (int i = 0; i < 16; ++i) { const v4u vw = vr[i];
                acc[8 * i + 0] += kw * bf_lo(vw.x); acc[8 * i + 1] += kw * bf_hi(vw.x); acc[8 * i + 2] += kw * bf_lo(vw.y); acc[8 * i + 3] += kw * bf_hi(vw.y);
                acc[8 * i + 4] += kw * bf_lo(vw.z); acc[8 * i + 5] += kw * bf_hi(vw.z); acc[8 * i + 6] += kw * bf_lo(vw.w); acc[8 * i + 7] += kw * bf_hi(vw.w);
                if (i == 7) asm volatile("" ::: "memory"); }
        }
        GAS f32x4* dst = (GAS f32x4*)(DC + ((size_t)unit * 64 + lane) * 128);
#pragma unroll
        for (int i = 0; i < 32; ++i) dst[i] = (f32x4){acc[4 * i], acc[4 * i + 1], acc[4 * i + 2], acc[4 * i + 3]};
        DN[(size_t)unit * 64 + lane] = dn;
        if (lane == 0) { BEND[unit] = bend; MLOC[unit] = mloc; }
    }
}
__device__ __forceinline__ void phase_mlstm_b(unsigned char* ws, int gtid, int NT) {
    float* DC = (float*)(ws + WS_DC); float* BEND = (float*)(ws + WS_SMALL); float* MLOC = BEND + 2048; float* MST = BEND + 2 * 2048; float* DN = BEND + 3 * 2048;
    for (int e = gtid; e < 16 * 8192 + 16 * 64; e += NT) {
        int bh; float* base; int stride; bool wm = false;
        if (e < 16 * 8192) { bh = e >> 13; base = DC + (size_t)bh * 128 * 8192 + (e & 8191); stride = 8192; }
        else { const int e2 = e - 16 * 8192; bh = e2 >> 6; base = DN + (size_t)bh * 128 * 64 + (e2 & 63); stride = 64; wm = (e2 & 63) == 0; }
        float mcur = 0.f, st = 0.f;
        for (int c0 = 0; c0 < NCH; c0 += 8) {
            float xv[8], be[8], ml[8];
#pragma unroll
            for (int i = 0; i < 8; ++i) { xv[i] = base[(size_t)(c0 + i) * stride]; be[i] = BEND[bh * 128 + c0 + i]; ml[i] = MLOC[bh * 128 + c0 + i]; }
#pragma unroll
            for (int i = 0; i < 8; ++i) {
                base[(size_t)(c0 + i) * stride] = st; if (wm) MST[bh * 128 + c0 + i] = mcur;
                const float mn = fmaxf(be[i] + mcur, ml[i]);
                st = expf(be[i] + mcur - mn) * st + expf(ml[i] - mn) * xv[i]; mcur = mn;
            }
        }
    }
}
__device__ __forceinline__ void phase_mlstm_c(const float* norm_h, unsigned char* ws, LAS unsigned char* lds, int gw, int NGW, int wave, int lane) {
    const bf16* QK = (const bf16*)(ws + WS_QKV); const float* GIF = (const float*)(ws + WS_GIF);
    const float* DC = (const float*)(ws + WS_DC); const float* BEND = (const float*)(ws + WS_SMALL); const float* MST = BEND + 2 * 2048; const float* DN = BEND + 3 * 2048;
    bf16* Y = (bf16*)(ws + WS_XN); const float* BCUM = (const float*)(ws + WS_USUM); const float* GMX = BCUM + (size_t)M * 8;
    LAS float* sl = (LAS float*)(lds + wave * 16384);
    for (int unit = gw; unit < 16 * NCH; unit += NGW) {
        const int bh = unit >> 7, c = unit & 127, b = bh >> 3, h = bh & 7, tok0 = b * T + c * LC, tok = tok0 + lane;
        const float li = GIF[(size_t)tok * 16 + h];
        const float bc = BCUM[(size_t)tok * 8 + h], g = li - bc, mxp = GMX[(size_t)tok * 8 + h], mc = MST[unit];
        const float mmax = fmaxf(mc, mxp), winter = expf(mc - mmax);
        float den = 0.f;
        {
            float q[64];
            const GAS v4u* qr = (const GAS v4u*)(QK + (size_t)tok * NIN_G + h * DQK);
#pragma unroll
            for (int i = 0; i < 8; ++i) { const v4u w = qr[i]; q[8 * i] = bf_lo(w.x); q[8 * i + 1] = bf_hi(w.x); q[8 * i + 2] = bf_lo(w.y); q[8 * i + 3] = bf_hi(w.y);
                q[8 * i + 4] = bf_lo(w.z); q[8 * i + 5] = bf_hi(w.z); q[8 * i + 6] = bf_lo(w.w); q[8 * i + 7] = bf_hi(w.w); }
    #pragma unroll 1
        for (int s = 0; s < LC; ++s) {
                const GAS v4u* kr = (const GAS v4u*)(QK + (size_t)(tok0 + s) * NIN_G + 512 + h * DQK); float dot = 0.f;
#pragma unroll
                for (int i = 0; i < 8; ++i) { const v4u kw = kr[i];
                    dot += (q[8 * i] * bf_lo(kw.x) + q[8 * i + 1] * bf_hi(kw.x)) + (q[8 * i + 2] * bf_lo(kw.y) + q[8 * i + 3] * bf_hi(kw.y)) + (q[8 * i + 4] * bf_lo(kw.z) + q[8 * i + 5] * bf_hi(kw.z)) + (q[8 * i + 6] * bf_lo(kw.w) + q[8 * i + 7] * bf_hi(kw.w)); }
                const float gs = rdlane_f(g, s); const float sv = (s <= lane) ? dot * expf(gs - mmax) : 0.f; den += sv;
                sl[s * 64 + lane] = sv;
            }
        }
        LDS_WAIT(); asm volatile("" ::: "memory");
        float acc[128];
#pragma unroll
        for (int v = 0; v < 128; ++v) acc[v] = 0.f;
#pragma unroll 1
        for (int s = 0; s < LC; ++s) {
            const float sv = sl[s * 64 + lane];
            const GAS v4u* vr = (const GAS v4u*)(QK + (size_t)(tok0 + s) * NIN_G + 1024 + h * DV);
#pragma unroll
            for (int i = 0; i < 16; ++i) { const v4u vw = vr[i];
                acc[8 * i + 0] += sv * bf_lo(vw.x); acc[8 * i + 1] += sv * bf_hi(vw.x); acc[8 * i + 2] += sv * bf_lo(vw.y); acc[8 * i + 3] += sv * bf_hi(vw.y);
                acc[8 * i + 4] += sv * bf_lo(vw.z); acc[8 * i + 5] += sv * bf_hi(vw.z); acc[8 * i + 6] += sv * bf_lo(vw.w); acc[8 * i + 7] += sv * bf_hi(vw.w);
                if (i == 7) asm volatile("" ::: "memory"); }
        }
        float qn = 0.f;
#pragma unroll 1
        for (int d = 0; d < DQK; ++d) {
            const float qd = bf1(QK[(size_t)tok * NIN_G + h * DQK + d]); qn += qd * DN[(size_t)unit * 64 + d]; const float qw = qd * winter;
            const GAS f32x4* cr = (const GAS f32x4*)(DC + ((size_t)unit * 64 + d) * 128);
#pragma unroll
            for (int i = 0; i < 32; ++i) { const f32x4 cv = cr[i]; acc[4 * i] += qw * cv.x; acc[4 * i + 1] += qw * cv.y; acc[4 * i + 2] += qw * cv.z; acc[4 * i + 3] += qw * cv.w;
                if ((i & 7) == 7) asm volatile("" ::: "memory"); }
        }
        den = winter * qn + den;
        const float inv = 1.0f / fmaxf(fabsf(den), expf(-(bc + mmax)));
        float ssq = 0.f;
#pragma unroll
        for (int v = 0; v < 128; ++v) { acc[v] *= inv; ssq += acc[v] * acc[v]; }
        const float rn = 1.0f / sqrtf(ssq * (1.0f / DV) + RMS_EPS);
        const GAS v4u* orow = (const GAS v4u*)(QK + (size_t)tok * NIN_G + 2048 + h * DV); GAS v4u* yrow = (GAS v4u*)(Y + (size_t)tok * D + h * DV);
        const float* nh = norm_h + h * DV;
#pragma unroll
        for (int i = 0; i < 16; ++i) { const v4u ow = orow[i]; float o[8] = {bf_lo(ow.x), bf_hi(ow.x), bf_lo(ow.y), bf_hi(ow.y), bf_lo(ow.z), bf_hi(ow.z), bf_lo(ow.w), bf_hi(ow.w)}; float y[8];
#pragma unroll
            for (int e = 0; e < 8; ++e) y[e] = acc[8 * i + e] * rn * nh[8 * i + e] * (1.0f / (1.0f + expf(-o[e])));
            v4u yw; yw.x = pk2(y[0], y[1]); yw.y = pk2(y[2], y[3]); yw.z = pk2(y[4], y[5]); yw.w = pk2(y[6], y[7]); yrow[i] = yw;
            if ((i & 3) == 3) asm volatile("" ::: "memory"); }
        LDS_WAIT(); asm volatile("" ::: "memory");
    }
}

struct Args { const float* in[13]; float* out; unsigned char* ws; };
__global__ void __launch_bounds__(NTHR, 2) fwd_kernel(Args args) {
    extern __shared__ __attribute__((aligned(16))) unsigned char lds_raw[];
    LAS unsigned char* lds = (LAS unsigned char*)lds_raw;
    volatile LAS unsigned* MISC = (volatile LAS unsigned*)(lds + MISC_OFF);
    const int wave = __builtin_amdgcn_readfirstlane((int)threadIdx.x >> 6);
    const int G = gridDim.x, wg = blockIdx.x;
#define FRESH int lane_ = (int)__lane_id(); asm volatile("" : "+v"(lane_)); const int lane = lane_; const int tid = wave * 64 + lane; (void)tid;
    const int gw = wg * NWAVES + wave, NGW = G * NWAVES;
    unsigned char* ws = args.ws;
    gu32* ctl = (gu32*)(ws + WS_CTL);
    { FRESH for (int u = tid; u < (LDS_BYTES - LDSCTL_OFF) / 4; u += NTHR) ((LAS unsigned*)(lds + LDSCTL_OFF))[u] = 0u; }
    __syncthreads();
    XcdBarrier bar = xcd_barrier_post((unsigned*)(ctl + CW_BAR), MISC + 8);
#define GRID_BAR() do { FRESH xcd_barrier(bar, tid == 0); } while (0)
    const float* x = args.in[0]; const float* g_mix_pre = args.in[1]; const float* g_mix_post = args.in[2]; const float* g_ffn_pre = args.in[3]; const float* g_ffn_post = args.in[4];
    const float* w_up = args.in[5]; const float* w_down = args.in[6]; const float* w_qkv = args.in[7]; const float* w_o = args.in[8];
    const float* w_in = args.in[9]; const float* b_gates = args.in[10]; const float* norm_h = args.in[11]; const float* w_out = args.in[12];
    float* out = args.out;
    bf16* W_IN = (bf16*)(ws + WS_W); bf16* W_OUT = (bf16*)(ws + WS_W + 6 * MiB); bf16* W_UP = (bf16*)(ws + WS_W + 8 * MiB); bf16* W_DN = (bf16*)(ws + WS_W + 16 * MiB);
    bf16* XN = (bf16*)(ws + WS_XN); bf16* QKV = (bf16*)(ws + WS_QKV); float* U = (float*)(ws + WS_U);

    { FRESH convert_weights(w_qkv, 3072, w_o, w_up, w_down, ws, lds, gw, NGW, wave, lane); }
    __syncthreads();
    { FRESH phase_p0(x, g_mix_pre, ws, lds, wg, G, tid, wave, lane); }
    GRID_BAR();
    {
        pg8::Gemm g{XN, W_IN, M, 3 * D, D}; pg8::StaticOrder S; S.init(M, 3 * D, G, wg);
        pg8::EpiBf16<0> E{QKV, D, D, (size_t)M * D, 0, D, QSCALE};
        FRESH pg8::gemm_phase<pg8::EpiBf16<0>, pg8::StaticOrder, true, true>(lds, g, S, E, tid);
    }
    { FRESH phase_kmean(w_qkv, ws, wg, G, wave, lane); }
    GRID_BAR();
    { FRESH phase_g(w_qkv, ws, wg, G, wave, lane); }
    GRID_BAR();
    { FRESH phase_gate_naive(x, g_mix_pre, ws, gw, NGW, lane); }
    GRID_BAR();
    { FRESH phase_lists(ws, gw, NGW, lane); }
    GRID_BAR();
    { FRESH phase_attn(ws, (char*)lds_raw, wg, G, tid); }
    GRID_BAR();
    { FRESH phase_combine(ws, wg * NTHR + tid, G * NTHR); }
    GRID_BAR();
    {
        pg8::Gemm g{XN, W_OUT, M, D, D}; pg8::StaticOrder S; S.init(M, D, G, wg);
        pg8::EpiF32 E{U, D};
        FRESH pg8::gemm_phase<pg8::EpiF32, pg8::StaticOrder, true, true>(lds, g, S, E, tid);
    }
    GRID_BAR();
    { FRESH norm_rows<true, false>(U, x, out, g_mix_post, g_ffn_pre, XN, nullptr, nullptr, nullptr, gw, NGW, lane); }
    GRID_BAR();
    {
        pg8::Gemm g{XN, W_UP, M, FF, D}; pg8::StaticOrder S; S.init(M, FF, G, wg);
        pg8::EpiBf16<2> E{QKV, FF, 0, 0, 0, 0, 1.f};
        FRESH pg8::gemm_phase<pg8::EpiBf16<2>, pg8::StaticOrder, true, true>(lds, g, S, E, tid);
    }
    GRID_BAR();
    {
        pg8::Gemm g{QKV, W_DN, M, D, FF}; pg8::StaticOrder S; S.init(M, D, G, wg);
        pg8::EpiF32 E{U, D};
        FRESH pg8::gemm_phase<pg8::EpiF32, pg8::StaticOrder, true, true>(lds, g, S, E, tid);
    }
    GRID_BAR();
    { FRESH convert_weights(w_in, NIN, w_out, w_up + (size_t)D * FF, w_down + (size_t)D * FF, ws, lds, gw, NGW, wave, lane); }
    __syncthreads();
    {
        LAS float* wgl = (LAS float*)lds;
        { FRESH for (int e = tid; e < 16 * 1024; e += NTHR) { const int k = e >> 4, gg = e & 15; wgl[gg * 1024 + k] = w_in[(size_t)k * NIN + NIN_G + gg]; } }
        __syncthreads();
        { FRESH norm_rows<true, true>(U, out, out, g_ffn_post, g_mix_pre + D, XN, wgl, b_gates, (float*)(ws + WS_GIF), gw, NGW, lane); }
    }
    GRID_BAR();
    {
        pg8::Gemm g{XN, W_IN, M, NIN_G, D}; pg8::StaticOrder S; S.init(M, NIN_G, G, wg);
        pg8::EpiBf16<0> E{QKV, NIN_G, 0, 0, 512, 1024, 0.125f};
        FRESH pg8::gemm_phase<pg8::EpiBf16<0>, pg8::StaticOrder, true, true>(lds, g, S, E, tid);
    }
    GRID_BAR();
    { FRESH phase_mlstm_a(ws, gw, NGW, lane); }
    GRID_BAR();
    { FRESH phase_mlstm_b(ws, wg * NTHR + tid, G * NTHR); }
    GRID_BAR();
    { FRESH phase_mlstm_c(norm_h, ws, lds, gw, NGW, wave, lane); }
    GRID_BAR();
    {
        pg8::Gemm g{XN, W_OUT, M, D, D}; pg8::StaticOrder S; S.init(M, D, G, wg);
        pg8::EpiF32 E{U, D};
        FRESH pg8::gemm_phase<pg8::EpiF32, pg8::StaticOrder, true, true>(lds, g, S, E, tid);
    }
    GRID_BAR();
    { FRESH norm_rows<true, false>(U, out, out, g_mix_post + D, g_ffn_pre + D, XN, nullptr, nullptr, nullptr, gw, NGW, lane); }
    GRID_BAR();
    {
        pg8::Gemm g{XN, W_UP, M, FF, D}; pg8::StaticOrder S; S.init(M, FF, G, wg);
        pg8::EpiBf16<2> E{QKV, FF, 0, 0, 0, 0, 1.f};
        FRESH pg8::gemm_phase<pg8::EpiBf16<2>, pg8::StaticOrder, true, true>(lds, g, S, E, tid);
    }
    GRID_BAR();
    {
        pg8::Gemm g{QKV, W_DN, M, D, FF}; pg8::StaticOrder S; S.init(M, D, G, wg);
        pg8::EpiF32 E{U, D};
        FRESH pg8::gemm_phase<pg8::EpiF32, pg8::StaticOrder, true, true>(lds, g, S, E, tid);
    }
    GRID_BAR();
    { FRESH norm_rows<false, false>(U, out, out, g_ffn_post + D, nullptr, nullptr, nullptr, nullptr, nullptr, gw, NGW, lane); }
}

extern "C" void kernel_launch(void* const* d_in, const int* in_sizes, int n_in, void* d_out, int out_size, void* d_ws, size_t ws_size, hipStream_t stream) {
    static int grid = 0;
    if (grid == 0) {
        if (n_in != 13 || in_sizes[0] != M * D || out_size != M * D || ws_size < WS_END) { fprintf(stderr, "kernel_launch: unexpected shapes (n_in %d in0 %d out %d ws %zu)\n", n_in, n_in > 0 ? in_sizes[0] : -1, out_size, ws_size); grid = -1; return; }
        int dev = 0, cus = 0;
        if (hipGetDevice(&dev) != hipSuccess || hipDeviceGetAttribute(&cus, hipDeviceAttributeMultiprocessorCount, dev) != hipSuccess) { grid = -1; return; }
        if (hipFuncSetAttribute((const void*)fwd_kernel, hipFuncAttributeMaxDynamicSharedMemorySize, LDS_BYTES) != hipSuccess) { fprintf(stderr, "kernel_launch: hipFuncSetAttribute failed\n"); grid = -1; return; }
        int per_cu = 0;
        if (hipOccupancyMaxActiveBlocksPerMultiprocessor(&per_cu, (const void*)fwd_kernel, NTHR, LDS_BYTES) != hipSuccess || per_cu < 1) fprintf(stderr, "kernel_launch: occupancy query reports %d\n", per_cu);
        (void)hipGetLastError();
        grid = cus;
    }
    if (grid < 0) return;
    if (hipMemsetAsync((char*)d_ws + WS_CTL, 0, CTL_ZERO_BYTES, stream) != hipSuccess) return;
    Args a{};
    for (int i = 0; i < 13; ++i) a.in[i] = (const float*)d_in[i];
    a.out = (float*)d_out; a.ws = (unsigned char*)d_ws;
    hipLaunchKernelGGL(fwd_kernel, dim3(grid), dim3(NTHR), LDS_BYTES, stream, a);
}
```

```cpp
#include <hip/hip_runtime.h>
#include <cstdio>
#include <cstdint>
#include <cmath>
namespace pg8 {
#define PG8_LAS __attribute__((address_space(3)))
typedef unsigned short bf16_t;
typedef short bf16x8 __attribute__((ext_vector_type(8)));
typedef float f32x4 __attribute__((ext_vector_type(4)));
typedef unsigned u32x4 __attribute__((ext_vector_type(4)));
constexpr int BM = 256, BK = 64, HALF = 128, HTB = HALF * BK * 2  , STAGE_BYTES = 8 * HTB, NXCD = 8, WGM = 8;

__host__ __device__ __forceinline__ int lds_byte(int r, int c) { const int st = (r >> 4) * 2 + (c >> 5), rr = r & 15, cc = c & 31, ob = rr * 64 + cc * 2; return st * 1024 + (ob ^ (((ob >> 9) & 1) << 5)); }
__host__ __device__ __forceinline__ void stage_rc(int b, int& R, int& C) { const int st = b / 1024, sb = b % 1024, swz = sb ^ (((sb >> 9) & 1) << 5); R = (st >> 1) * 16 + swz / 64; C = (st & 1) * 32 + (swz % 64) / 2; }
__host__ __device__ __forceinline__ int perm32(int rho) { const int n = rho >> 4, i = rho & 15; return 8 * (i >> 2) + 4 * n + (i & 3); }

struct Unit { int pm, pn; };
struct Gemm { const bf16_t* A; const bf16_t* Bt; int M, N, K; };

struct StaticOrder {
    int nM, nN, nwg, G, c;
    __host__ __device__ void init(int M, int N, int G_, int c_) { nM = M / BM; nN = N / BM; nwg = nM * nN; G = G_; c = c_; }
    __host__ __device__ bool next(int i, Unit& u) const {
        const long L = (long)i * G + c; if (L >= nwg) return false;
        int wgid = (int)L; { const int q = nwg / NXCD, r = nwg % NXCD, xcd = wgid % NXCD, off = wgid / NXCD; wgid = (xcd < r ? xcd * (q + 1) : r * (q + 1) + (xcd - r) * q) + off; }
        const int nig = WGM * nN, gid = wgid / nig, fm = gid * WGM, gsz = (nM - fm) < WGM ? (nM - fm) : WGM;
        u.pm = fm + ((wgid % nig) % gsz); u.pn = (wgid % nig) / gsz; return true;
    }
    __device__ __forceinline__ void a_ready(const Unit&) const {}
    __device__ __forceinline__ void done(const Unit&) const {}
};

__device__ __forceinline__ unsigned cvt_pk_bf16(float lo, float hi) { unsigned r; asm volatile("v_cvt_pk_bf16_f32 %0, %1, %2" : "=v"(r) : "v"(lo), "v"(hi)); return r; }
typedef float f32x2 __attribute__((ext_vector_type(2)));
template <int ACT> struct EpiBf16 {
    static constexpr bool PERM = true, AFTER_DRAIN = false;
    bf16_t* O; int ldc; int split_cols; size_t split_stride; int sc_lo, sc_hi; float scale;
    __device__ __forceinline__ void operator()(const f32x4 (&acc)[2][2][4][2], const Unit& u, int wr, int wc, int fr, int fq) const {
        const int row0 = u.pm * BM + wr * 64 + fr; int colt = u.pn * BM; bf16_t* base = O;
        const float sc = (colt >= sc_lo && colt < sc_hi) ? scale : 1.f;
        if (split_cols) { const int t = colt / split_cols; base += (size_t)t * split_stride; colt -= t * split_cols; }
        const int col0 = colt + wc * 32 + 8 * fq;
#pragma unroll
        for (int ai = 0; ai < 2; ++ai)
#pragma unroll
            for (int m = 0; m < 4; ++m) { bf16_t* rowp = base + (size_t)(row0 + ai * HALF + m * 16) * ldc + col0;
#pragma unroll
                for (int bj = 0; bj < 2; ++bj) { f32x4 v0 = acc[ai][bj][m][0], v1 = acc[ai][bj][m][1];
                    if (ACT == 2) {
#pragma unroll
                        for (int e = 0; e < 4; ++e) { const float a = fmaxf(v0[e], 0.f), b = fmaxf(v1[e], 0.f); v0[e] = a * a; v1[e] = b * b; } }
                    v0 = v0 * sc; v1 = v1 * sc; u32x4 w; w.x = cvt_pk_bf16(v0[0], v0[1]); w.y = cvt_pk_bf16(v0[2], v0[3]); w.z = cvt_pk_bf16(v1[0], v1[1]); w.w = cvt_pk_bf16(v1[2], v1[3]);
                    *(u32x4*)(rowp + bj * HALF) = w; } }
    }
};
struct EpiF32 {
    static constexpr bool PERM = false, AFTER_DRAIN = false;
    float* O; int ldc;
    __device__ __forceinline__ void operator()(const f32x4 (&acc)[2][2][4][2], const Unit& u, int wr, int wc, int fr, int fq) const {
        const int col0 = u.pn * BM + wc * 32 + 4 * fq;
#pragma unroll
        for (int ai = 0; ai < 2; ++ai)
#pragma unroll
            for (int m = 0; m < 4; ++m) { const int r = ai * HALF + wr * 64 + m * 16 + fr; const size_t off = (size_t)(u.pm * BM + r) * ldc + col0;
#pragma unroll
                for (int bj = 0; bj < 2; ++bj)
#pragma unroll
                    for (int n = 0; n < 2; ++n) *(f32x4*)(O + off + bj * HALF + n * 16) = acc[ai][bj][m][n]; }
    }
};

template <class Epi, class Sched, bool ALIGN_EPI = false, bool SP2 = false>
__device__ __forceinline__ void gemm_phase(PG8_LAS unsigned char* lds, const Gemm g, const Sched& S, const Epi& E, int tid_in) {
    int tid_ = tid_in; asm volatile("" : "+v"(tid_));
    const int tid = tid_, wid = __builtin_amdgcn_readfirstlane(tid >> 6), lane = tid & 63, wr = wid >> 2, wc = wid & 3, fr = lane & 15, fq = lane >> 4;
    const int K = g.K, nt = K / BK;
    unsigned voffA[2], voffB[2];
#pragma unroll
    for (int i = 0; i < 2; ++i) { int R, C; stage_rc(tid * 16 + i * 8192, R, C); const int Rb = Epi::PERM ? ((R & ~31) + perm32(R & 31)) : R;
        voffA[i] = (unsigned)(R * K + C) * 2u; voffB[i] = (unsigned)(Rb * K + C) * 2u; }
    const size_t kstep = (size_t)(BK * 2);
    const size_t hstep = (size_t)HALF * K * 2;
    const size_t tstep = 2 * hstep;
    const unsigned ldsw = (unsigned)wid * 1024u;
    const int aoff = lds_byte(wr * 64 + fr, fq * 8), boff = lds_byte(wc * 32 + fr, fq * 8);
#define PG8_SA(b, h) (((b) * 2 + (h)) * HTB)
#define PG8_SB(b, h) ((4 + (b) * 2 + (h)) * HTB)
#define PG8_STAGE(bufoff, gbase, voff) do { _Pragma("unroll") for (int _i = 0; _i < 2; ++_i) \
        __builtin_amdgcn_global_load_lds((const unsigned*)((const char*)(gbase) + (voff)[_i]), (PG8_LAS unsigned*)(lds + (bufoff) + ldsw + _i * 8192), 16, 0, 0); } while (0)
#define PG8_LDA(dst, b, h) do { _Pragma("unroll") for (int m = 0; m < 4; ++m) _Pragma("unroll") for (int k = 0; k < 2; ++k) dst[m][k] = *(const PG8_LAS bf16x8*)(lds + PG8_SA(b, h) + aoff + m * 2048 + k * 1024); } while (0)
#define PG8_LDB(dst, b, h) do { _Pragma("unroll") for (int n = 0; n < 2; ++n) _Pragma("unroll") for (int k = 0; k < 2; ++k) dst[n][k] = *(const PG8_LAS bf16x8*)(lds + PG8_SB(b, h) + boff + n * 2048 + k * 1024); } while (0)
#define PG8_MMA(ai, bj, At, Bt) do { __builtin_amdgcn_s_setprio(1); _Pragma("unroll") for (int m = 0; m < 4; ++m) _Pragma("unroll") for (int n = 0; n < 2; ++n) _Pragma("unroll") for (int k = 0; k < 2; ++k) \
        acc[ai][bj][m][n] = __builtin_amdgcn_mfma_f32_16x16x32_bf16(Bt[n][k], At[m][k], acc[ai][bj][m][n], 0, 0, 0); __builtin_amdgcn_s_setprio(0); } while (0)
#define PG8_WAIT_V(n) asm volatile("s_waitcnt vmcnt(" #n ")" ::: "memory")
#define PG8_WAIT_L(n) asm volatile("s_waitcnt lgkmcnt(" #n ")" ::: "memory")
#define PG8_BAR __builtin_amdgcn_s_barrier()
#define PG8_SCHED __builtin_amdgcn_sched_barrier(0)
    Unit cur, nxt; int ui = 0;
    if (!S.next(0, cur)) return;
    f32x4 acc[2][2][4][2];
#pragma unroll
    for (int a = 0; a < 2; ++a)
#pragma unroll
        for (int b = 0; b < 2; ++b)
#pragma unroll
            for (int m = 0; m < 4; ++m)
#pragma unroll
                for (int n = 0; n < 2; ++n) acc[a][b][m][n] = (f32x4){0.f, 0.f, 0.f, 0.f};
    bf16x8 At[4][2], B0[2][2], B1[2][2];
    const char* cA = (const char*)g.A + (size_t)cur.pm * tstep; const char* cB = (const char*)g.Bt + (size_t)cur.pn * tstep;
    S.a_ready(cur);
    if constexpr (SP2) {
        PG8_STAGE(PG8_SB(0, 0), cB, voffB); PG8_STAGE(PG8_SB(0, 1), cB + hstep, voffB); PG8_STAGE(PG8_SA(0, 0), cA, voffA); PG8_STAGE(PG8_SA(0, 1), cA + hstep, voffA);
        if (wr == 1) PG8_BAR;
        PG8_WAIT_V(2); PG8_BAR;
        PG8_STAGE(PG8_SB(1, 0), cB + kstep, voffB); PG8_STAGE(PG8_SA(1, 0), cA + kstep, voffA); PG8_STAGE(PG8_SB(1, 1), cB + hstep + kstep, voffB);
        PG8_WAIT_V(6); PG8_BAR;
    } else {
        PG8_STAGE(PG8_SB(0, 0), cB, voffB); PG8_STAGE(PG8_SA(0, 0), cA, voffA); PG8_STAGE(PG8_SB(0, 1), cB + hstep, voffB); PG8_STAGE(PG8_SA(0, 1), cA + hstep, voffA);
        if (wr == 1) PG8_BAR;
        PG8_WAIT_V(4); PG8_BAR;
        PG8_STAGE(PG8_SB(1, 0), cB + kstep, voffB); PG8_STAGE(PG8_SA(1, 0), cA + kstep, voffA); PG8_STAGE(PG8_SB(1, 1), cB + hstep + kstep, voffB);
        PG8_WAIT_V(6); PG8_BAR;
    }
    for (;;) {
        const bool has_next = S.next(ui + 1, nxt);
        const char* nA = has_next ? (const char*)g.A + (size_t)nxt.pm * tstep : cA; const char* nB = has_next ? (const char*)g.Bt + (size_t)nxt.pn * tstep : cB;
        for (int t = 0; t < nt; t += 2) {
            const bool last = (t == nt - 2);
            const char* a1 = cA + (size_t)(t + 1) * kstep;
            const char* a2 = last ? nA : cA + (size_t)(t + 2) * kstep; const char* b2 = last ? nB : cB + (size_t)(t + 2) * kstep;
            const char* a3 = a2 + kstep; const char* b3 = b2 + kstep;
            if (last && has_next) S.a_ready(nxt);
            if constexpr (SP2) {
            PG8_LDB(B0, 0, 0); PG8_LDB(B1, 0, 1); PG8_SCHED; PG8_LDA(At, 0, 0); PG8_STAGE(PG8_SA(1, 1), a1 + hstep, voffA);
            PG8_WAIT_V(8); PG8_WAIT_L(0); PG8_BAR; PG8_MMA(0, 0, At, B0); PG8_MMA(0, 1, At, B1); PG8_BAR; PG8_SCHED;
            PG8_LDA(At, 0, 1); PG8_STAGE(PG8_SB(0, 0), b2, voffB); PG8_STAGE(PG8_SB(0, 1), b2 + hstep, voffB); PG8_STAGE(PG8_SA(0, 0), a2, voffA);
            PG8_WAIT_V(8); PG8_WAIT_L(0); PG8_BAR; PG8_MMA(1, 0, At, B0); PG8_MMA(1, 1, At, B1); PG8_BAR; PG8_SCHED;
            PG8_LDB(B0, 1, 0); PG8_LDB(B1, 1, 1); PG8_SCHED; PG8_LDA(At, 1, 0); PG8_STAGE(PG8_SA(0, 1), a2 + hstep, voffA);
            PG8_WAIT_V(8); PG8_WAIT_L(0); PG8_BAR; PG8_MMA(0, 0, At, B0); PG8_MMA(0, 1, At, B1); PG8_BAR; PG8_SCHED;
            PG8_LDA(At, 1, 1); PG8_STAGE(PG8_SB(1, 0), b3, voffB); PG8_STAGE(PG8_SB(1, 1), b3 + hstep, voffB); PG8_STAGE(PG8_SA(1, 0), a3, voffA);
            PG8_WAIT_V(8); PG8_WAIT_L(0); PG8_BAR; PG8_MMA(1, 0, At, B0); PG8_MMA(1, 1, At, B1); PG8_BAR; PG8_SCHED;
            } else {
            PG8_LDB(B0, 0, 0); PG8_SCHED; PG8_LDA(At, 0, 0); PG8_STAGE(PG8_SA(1, 1), a1 + hstep, voffA);
            PG8_WAIT_L(8); PG8_BAR; PG8_WAIT_L(0); PG8_MMA(0, 0, At, B0); PG8_BAR; PG8_SCHED;
            PG8_LDB(B1, 0, 1); PG8_STAGE(PG8_SB(0, 0), b2, voffB);
            PG8_BAR; PG8_WAIT_L(0); PG8_MMA(0, 1, At, B1); PG8_BAR;
            PG8_LDA(At, 0, 1); PG8_STAGE(PG8_SA(0, 0), a2, voffA);
            PG8_BAR; PG8_WAIT_L(0); PG8_MMA(1, 0, At, B0); PG8_BAR; PG8_SCHED;
            PG8_STAGE(PG8_SB(0, 1), b2 + hstep, voffB);
            PG8_WAIT_V(6); PG8_BAR; PG8_MMA(1, 1, At, B1); PG8_BAR;
            PG8_LDB(B0, 1, 0); PG8_SCHED; PG8_LDA(At, 1, 0); PG8_STAGE(PG8_SA(0, 1), a2 + hstep, voffA);
            PG8_WAIT_L(8); PG8_BAR; PG8_WAIT_L(0); PG8_MMA(0, 0, At, B0); PG8_BAR; PG8_SCHED;
            PG8_LDB(B1, 1, 1); PG8_STAGE(PG8_SB(1, 0), b3, voffB);
            PG8_BAR; PG8_WAIT_L(0); PG8_MMA(0, 1, At, B1); PG8_BAR;
            PG8_LDA(At, 1, 1); PG8_STAGE(PG8_SA(1, 0), a3, voffA);
            PG8_BAR; PG8_WAIT_L(0); PG8_MMA(1, 0, At, B0); PG8_BAR; PG8_SCHED;
            PG8_STAGE(PG8_SB(1, 1), b3 + hstep, voffB);
            PG8_WAIT_V(6); PG8_BAR; PG8_MMA(1, 1, At, B1); PG8_BAR;
            }
        }
        if constexpr (ALIGN_EPI) { if (wr == 0) PG8_BAR; }
        if constexpr (!Epi::AFTER_DRAIN) { E(acc, cur, wr, wc, fr, fq); S.done(cur); }
        if (!has_next) break;
#pragma unroll
        for (int a = 0; a < 2; ++a)
#pragma unroll
            for (int b = 0; b < 2; ++b)
#pragma unroll
                for (int m = 0; m < 4; ++m)
#pragma unroll
                    for (int n = 0; n < 2; ++n) acc[a][b][m][n] = (f32x4){0.f, 0.f, 0.f, 0.f};
        cur = nxt; cA = nA; cB = nB; ++ui;
        if constexpr (ALIGN_EPI) { if (wr == 1) PG8_BAR; }
    }
    PG8_WAIT_V(0);
    if constexpr (!ALIGN_EPI) { if (wr == 0) PG8_BAR; }
    PG8_BAR;
    if constexpr (Epi::AFTER_DRAIN) { E.fused(acc, cur, wr, wc, fr, fq, lds, wid, lane); S.done(cur); }
#undef PG8_SA
#undef PG8_SB
#undef PG8_STAGE
#undef PG8_LDA
#undef PG8_LDB
#undef PG8_MMA
#undef PG8_WAIT_V
#undef PG8_WAIT_L
#undef PG8_BAR
#undef PG8_SCHED
}
}
#define GAS __attribute__((address_space(1)))
#define LAS __attribute__((address_space(3)))
typedef unsigned short bf16;
typedef unsigned v4u __attribute__((ext_vector_type(4)));
typedef float f32x4 __attribute__((ext_vector_type(4)));
typedef short bf16x8 __attribute__((ext_vector_type(8)));
typedef GAS unsigned gu32;
typedef GAS unsigned long long gu64;
#define RLX_AGENT __ATOMIC_RELAXED, __HIP_MEMORY_SCOPE_AGENT
#define LDS_WAIT() asm volatile("s_waitcnt lgkmcnt(0)" ::: "memory")
#define VM_WAIT() asm volatile("s_waitcnt vmcnt(0)" ::: "memory")
__device__ __forceinline__ unsigned long long rt() { return __builtin_amdgcn_s_memrealtime(); }
__device__ __forceinline__ unsigned f2bf(float f) { unsigned u = __builtin_bit_cast(unsigned, f); return (u + 0x7fffu + ((u >> 16) & 1u)) >> 16; }
__device__ __forceinline__ unsigned pk2(float lo, float hi) { return f2bf(lo) | (f2bf(hi) << 16); }

#define XB_TMO      128
#define XB_XCNT(j)  (256  + 64 * (j))
#define XB_XSUB(j)  (1280 + 64 * (j))
#define XB_XGEN(j)  (2304 + 64 * (j))
#define XB_TOP      3328
#define XB_TOPGEN   3392
#define XCD_BAR_WORDS 3456
#define XB_SPIN_CAP (1u << 21)

__device__ __forceinline__ unsigned xb_ld(unsigned* p)              { return __hip_atomic_load(p, __ATOMIC_RELAXED, __HIP_MEMORY_SCOPE_AGENT); }
__device__ __forceinline__ unsigned xb_add(unsigned* p, unsigned v) { return __hip_atomic_fetch_add(p, v, __ATOMIC_RELAXED, __HIP_MEMORY_SCOPE_AGENT); }
__device__ __forceinline__ unsigned xb_xcc_id() { return (unsigned)__builtin_amdgcn_s_getreg((3 << 11) | 20) & 0xFu; }
#define XB_SPIN(cond, bar) do { unsigned _sp = 0; while (cond) { __builtin_amdgcn_s_sleep(1); \
    if ((++_sp & 255u) == 0u) { if (xb_ld(&(bar)[XB_TMO])) break; if (_sp > XB_SPIN_CAP) { atomicAdd(&(bar)[XB_TMO], 1u); break; } } } } while (0)

struct XcdBarrier {
    unsigned* bar; unsigned x;
    volatile LAS unsigned* st;
};

__device__ __forceinline__ XcdBarrier xcd_barrier_post(unsigned* bar, volatile LAS unsigned* st) {
    XcdBarrier b; b.bar = bar; b.x = xb_xcc_id(); b.st = st;
    if (threadIdx.x == 0) (void)xb_add(&bar[XB_XCNT(b.x)], 1u);
    return b;
}
__device__ __forceinline__ void xcd_barrier_complete(unsigned* bar, unsigned x, unsigned& nloc, unsigned& nx) {
    const unsigned G = gridDim.x * gridDim.y * gridDim.z;
    unsigned sum, cnt, mine, sp = 0u;
    for (;;) {
        sum = 0u; cnt = 0u; mine = 0u;
#pragma unroll
        for (unsigned j = 0; j < 16; ++j) { const unsigned c = xb_ld(&bar[XB_XCNT(j)]); sum += c; cnt += (c > 0u) ? 1u : 0u; mine = (j == x) ? c : mine; }
        if (sum == G) break;
        __builtin_amdgcn_s_sleep(1);
        if ((++sp & 255u) == 0u) { if (xb_ld(&bar[XB_TMO])) break; if (sp > XB_SPIN_CAP) { atomicAdd(&bar[XB_TMO], 1u); break; } }
    }
    nloc = mine > 0u ? mine : 1u; nx = cnt > 0u ? cnt : 1u;
}

__device__ __forceinline__ void xcd_barrier(const XcdBarrier& b, const bool is_t0  ) {
    asm volatile("s_waitcnt vmcnt(0)" ::: "memory");
    __syncthreads();
    if (is_t0) {
        unsigned* bar = b.bar;
        __builtin_amdgcn_s_waitcnt(0);
        unsigned nloc = b.st[0], nx = b.st[1];
        if (nloc == 0u) { xcd_barrier_complete(bar, b.x, nloc, nx); b.st[0] = nloc; b.st[1] = nx; }
        const unsigned old = xb_add(&bar[XB_XSUB(b.x)], 1u);
        const unsigned gen = old / nloc;
        if (old + 1u == (gen + 1u) * nloc) {
            __builtin_amdgcn_fence(__ATOMIC_RELEASE, "agent");
            asm volatile("s_waitcnt vmcnt(0)" ::: "memory");
            const unsigned og = xb_add(&bar[XB_TOP], 1u);
            const unsigned tg = og / nx;
            if (og + 1u == (tg + 1u) * nx) xb_add(&bar[XB_TOPGEN], 1u);
            else XB_SPIN(xb_ld(&bar[XB_TOPGEN]) == tg, bar);
            __builtin_amdgcn_fence(__ATOMIC_ACQUIRE, "agent");
            xb_add(&bar[XB_XGEN(b.x)], 1u);
            asm volatile("s_waitcnt vmcnt(0)" ::: "memory");
        } else {
            XB_SPIN(xb_ld(&bar[XB_XGEN(b.x)]) == gen, bar);
            __builtin_amdgcn_fence(__ATOMIC_ACQUIRE, "agent");
            asm volatile("s_waitcnt vmcnt(0)" ::: "memory");
        }
    }
    __syncthreads();
}

namespace moba {
using bf16x8 = __attribute__((ext_vector_type(8))) short;
using s16x4  = __attribute__((ext_vector_type(4))) short;
using f32x16 = __attribute__((ext_vector_type(16))) float;
using u32x4  = __attribute__((ext_vector_type(4))) unsigned;
typedef unsigned short bf16;
constexpr int KVBLK = 64, LDK = 1024, NT = 4;
constexpr int SHM_V = KVBLK * 128 * 2, SHM_K = SHM_V;
constexpr int OFF_WS = 2 * SHM_V + 2 * SHM_K, OFF_RO = OFF_WS + 8 * 64 * 4, LDS_ATTN = OFF_RO + 8 * 32 * 4;
constexpr float THR2 = 11.5f;
#define KSWZ(row, colB) ((row) * 256 + ((colB) ^ (((row) & 7) << 4)))
#define SBAR() __builtin_amdgcn_sched_barrier(0)
__device__ __forceinline__ int crow(int r, int hi) { return (r & 3) + 8 * (r >> 2) + 4 * hi; }
__device__ __forceinline__ unsigned cvtpk(float lo, float hi) { unsigned r; asm volatile("v_cvt_pk_bf16_f32 %0, %1, %2" : "=v"(r) : "v"(lo), "v"(hi)); return r; }

__device__ __forceinline__ void partialSM(f32x16& p0, f32x16& p1, float& m_reg, float& mn, float& alpha) {
  float pmax = p0[0];
#pragma unroll
  for (int r = 1; r < 16; ++r) pmax = fmaxf(pmax, p0[r]);
#pragma unroll
  for (int r = 0; r < 16; ++r) pmax = fmaxf(pmax, p1[r]);
  { auto rr = __builtin_amdgcn_permlane32_swap(__float_as_uint(pmax), __float_as_uint(pmax), false, false);
    pmax = fmaxf(__uint_as_float(rr[0]), __uint_as_float(rr[1])); }
  if (__builtin_expect(__all(pmax - m_reg <= THR2), 1)) { mn = m_reg; alpha = 1.f; }
  else { mn = fmaxf(m_reg, pmax); alpha = __builtin_amdgcn_exp2f(m_reg - mn); m_reg = mn; }
#pragma unroll
  for (int r = 0; r < 16; ++r) { p0[r] = p0[r] - mn; p1[r] = p1[r] - mn; }
#pragma unroll
  for (int r = 0; r < 16; ++r) p0[r] = __builtin_amdgcn_exp2f(p0[r]);
}
__device__ __forceinline__ void finishSM(f32x16& p0, f32x16& p1, float alpha, float& l_reg, bf16x8& pa0, bf16x8& pa1, bf16x8& pa2, bf16x8& pa3) {
#pragma unroll
  for (int r = 0; r < 16; ++r) p1[r] = __builtin_amdgcn_exp2f(p1[r]);
  float ps = 0;
#pragma unroll
  for (int r = 0; r < 16; ++r) ps += p0[r];
#pragma unroll
  for (int r = 0; r < 16; ++r) ps += p1[r];
  { auto rr = __builtin_amdgcn_permlane32_swap(__float_as_uint(ps), __float_as_uint(ps), false, false);
    ps = __uint_as_float(rr[0]) + __uint_as_float(rr[1]); }
  l_reg = l_reg * alpha + ps;
#define PK4(P, BASE, OUT) do { unsigned a0 = cvtpk(P[BASE + 0], P[BASE + 1]), a1 = cvtpk(P[BASE + 2], P[BASE + 3]);   \
    unsigned b0 = cvtpk(P[BASE + 4], P[BASE + 5]), b1 = cvtpk(P[BASE + 6], P[BASE + 7]);                              \
    auto r0 = __builtin_amdgcn_permlane32_swap(a0, b0, false, false); auto r1 = __builtin_amdgcn_permlane32_swap(a1, b1, false, false); \
    u32x4 w = {r0[0], r1[0], r0[1], r1[1]}; OUT = *reinterpret_cast<bf16x8*>(&w); } while (0)
  PK4(p0, 0, pa0); PK4(p0, 8, pa1); PK4(p1, 0, pa2); PK4(p1, 8, pa3);
#undef PK4
}
__device__ __forceinline__ void qkt(f32x16& p0, f32x16& p1, const char* Ks, const bf16x8* qr, int r32, int hi) {
  p0 = f32x16{}; p1 = f32x16{};
#pragma unroll
  for (int d0 = 0; d0 < 8; ++d0) { int cb = (d0 * 16 + hi * 8) * 2;
    bf16x8 b0 = *reinterpret_cast<const bf16x8*>(Ks + KSWZ(r32, cb));
    bf16x8 b1 = *reinterpret_cast<const bf16x8*>(Ks + KSWZ(32 + r32, cb));
    p0 = __builtin_amdgcn_mfma_f32_32x32x16_bf16(b0, qr[d0], p0, 0, 0, 0);
    p1 = __builtin_amdgcn_mfma_f32_32x32x16_bf16(b1, qr[d0], p1, 0, 0, 0); }
}
__device__ __forceinline__ void bias_mask(f32x16& p0, f32x16& p1, float tb, float sl2, int lim) {
#pragma unroll
  for (int r = 0; r < 16; ++r) { const int c = (r & 3) + 8 * (r >> 2);
    p0[r] += fmaf(sl2, (float)c, tb); p1[r] += fmaf(sl2, (float)(c + 32), tb);
    if (c > lim) p0[r] = -INFINITY; if (c + 32 > lim) p1[r] = -INFINITY; }
}
__device__ __forceinline__ int v_st(int k, int c) { const int kk = (k & ~0xC) | ((k & 4) << 1) | ((k & 8) >> 1); return ((kk >> 3) * 4 + (c >> 5)) * 512 + ((kk & 7) * 32 + (c & 31)) * 2; }
__device__ __forceinline__ int v_rd_base(int lane) { return ((lane & 3) << 3) | (((lane >> 2) & 3) << 6) | (((lane >> 4) & 1) << 5) | (((lane >> 5) & 1) << 8); }
constexpr int v_rd_off(int d0, int ks, int half) { return d0 * 512 + ks * 4096 + half * 2048; }
template <int OFF> __device__ __forceinline__ s16x4 tr_read(int vb) {
  s16x4 r; asm volatile("ds_read_b64_tr_b16 %0, %1 offset:%2" : "=&v"(r) : "v"(vb), "i"(OFF) : "memory"); return r;
}
template <int D0> __device__ __forceinline__ void pv_one(f32x16& od, int vb, bf16x8 pa0, bf16x8 pa1, bf16x8 pa2, bf16x8 pa3) {
  const s16x4 l0 = tr_read<v_rd_off(D0, 0, 0)>(vb), h0 = tr_read<v_rd_off(D0, 0, 1)>(vb), l1 = tr_read<v_rd_off(D0, 1, 0)>(vb), h1 = tr_read<v_rd_off(D0, 1, 1)>(vb);
  const s16x4 l2 = tr_read<v_rd_off(D0, 2, 0)>(vb), h2 = tr_read<v_rd_off(D0, 2, 1)>(vb), l3 = tr_read<v_rd_off(D0, 3, 0)>(vb), h3 = tr_read<v_rd_off(D0, 3, 1)>(vb);
  asm volatile("s_waitcnt lgkmcnt(0)" ::: "memory"); SBAR();
#define PK(L, H) (bf16x8){L[0], L[1], L[2], L[3], H[0], H[1], H[2], H[3]}
  od = __builtin_amdgcn_mfma_f32_32x32x16_bf16(pa0, PK(l0, h0), od, 0, 0, 0);
  od = __builtin_amdgcn_mfma_f32_32x32x16_bf16(pa1, PK(l1, h1), od, 0, 0, 0);
  od = __builtin_amdgcn_mfma_f32_32x32x16_bf16(pa2, PK(l2, h2), od, 0, 0, 0);
  od = __builtin_amdgcn_mfma_f32_32x32x16_bf16(pa3, PK(l3, h3), od, 0, 0, 0);
#undef PK
}
__device__ __forceinline__ void pv_d0(f32x16* o, int vb, bf16x8 pa0, bf16x8 pa1, bf16x8 pa2, bf16x8 pa3) {
  pv_one<0>(o[0], vb, pa0, pa1, pa2, pa3); pv_one<1>(o[1], vb, pa0, pa1, pa2, pa3); pv_one<2>(o[2], vb, pa0, pa1, pa2, pa3); pv_one<3>(o[3], vb, pa0, pa1, pa2, pa3);
}

__device__ __forceinline__ void attn_unit(const bf16* Qw, const bf16* Kh, const bf16* Vh, float lsecorr, int qlim, float sl2, bool valid, unsigned outoff, bf16* obase, float* lse, char* lds, int tid) {
  const int wid = tid >> 6, lane = tid & 63, r32 = lane & 31, hi = lane >> 5;
  char* V_lds = lds; char* K_lds = lds + 2 * SHM_V;
  float* wsf = (float*)(lds + OFF_WS) + wid * 64; float* li_l = wsf; float* al_l = wsf + 32; unsigned* ro_l = (unsigned*)(lds + OFF_RO) + wid * 32;
  float m_reg = -1e30f, l_reg = 0; f32x16 o[4] = {}; bf16x8 qr[8];
#pragma unroll
  for (int d0 = 0; d0 < 8; ++d0) qr[d0] = *reinterpret_cast<const bf16x8*>(Qw + d0 * 16);
  const int sr = tid >> 4, sc = (tid & 15) * 8, vst0 = v_st(sr, sc), vst1 = v_st(32 + sr, sc);
  const int vb0 = (int)(uintptr_t)V_lds + v_rd_base(lane);
  bf16x8 vs0, vs1, ks0, ks1;
#define SLOAD(k0) do { vs0 = *reinterpret_cast<const bf16x8*>(&Vh[(long)((k0) + sr) * LDK + sc]); vs1 = *reinterpret_cast<const bf16x8*>(&Vh[(long)((k0) + 32 + sr) * LDK + sc]); \
    ks0 = *reinterpret_cast<const bf16x8*>(&Kh[(long)((k0) + sr) * LDK + sc]); ks1 = *reinterpret_cast<const bf16x8*>(&Kh[(long)((k0) + 32 + sr) * LDK + sc]); } while (0)
#define SWRITE(b) do { *(bf16x8*)(V_lds + (b) * SHM_V + vst0) = vs0; *(bf16x8*)(V_lds + (b) * SHM_V + vst1) = vs1; const int kc = sc * 2; \
    *(bf16x8*)(K_lds + (b) * SHM_K + KSWZ(sr, kc)) = ks0; *(bf16x8*)(K_lds + (b) * SHM_K + KSWZ(32 + sr, kc)) = ks1; } while (0)
  const float tb0 = sl2 * (float)(4 * hi), tstep = sl2 * 64.f; const int lim0 = qlim - 4 * hi;
  SLOAD(0); SWRITE(0); __syncthreads();
#pragma unroll
  for (int t = 0; t < NT; ++t) {
    if (t + 1 < NT) SLOAD((t + 1) * KVBLK);
    f32x16 p0, p1; float mn, alpha; bf16x8 pa0, pa1, pa2, pa3;
    qkt(p0, p1, K_lds + (t & 1) * SHM_K, qr, r32, hi);
    bias_mask(p0, p1, tb0 + tstep * (float)t, sl2, lim0 - 64 * t);
    partialSM(p0, p1, m_reg, mn, alpha);
    finishSM(p0, p1, alpha, l_reg, pa0, pa1, pa2, pa3);
    if (__any(alpha < 1.f)) { if (hi == 0) al_l[r32] = alpha; asm volatile("s_waitcnt lgkmcnt(0)" ::: "memory");
#pragma unroll
      for (int d = 0; d < 4; ++d)
#pragma unroll
        for (int r = 0; r < 16; ++r) o[d][r] *= al_l[crow(r, hi)]; }
    SBAR();
    pv_d0(o, vb0 + (t & 1) * SHM_V, pa0, pa1, pa2, pa3);
    if (t + 1 < NT) { SWRITE((t + 1) & 1); __syncthreads(); }
  }
  if (hi == 0) { li_l[r32] = l_reg; ro_l[r32] = valid ? outoff : 0xffffffffu; if (valid) *lse = m_reg + __builtin_amdgcn_logf(l_reg) + lsecorr; }
  asm volatile("s_waitcnt lgkmcnt(0)" ::: "memory");
#pragma unroll
  for (int r = 0; r < 16; ++r) { const int orow = crow(r, hi); const float rl = __builtin_amdgcn_rcpf(li_l[orow]); const unsigned off = ro_l[orow];
    if (off != 0xffffffffu) {
#pragma unroll
      for (int d0 = 0; d0 < 4; ++d0) obase[(size_t)off + d0 * 32 + r32] = (bf16)(cvtpk(o[d0][r] * rl, 0.f) & 0xffffu); } }
  __syncthreads();
#undef SLOAD
#undef SWRITE
}
#undef KSWZ
#undef SBAR
}

constexpr int NWAVES = 8, NTHR = NWAVES * 64;
constexpr int BATCH = 2, T = 8192, D = 1024, M = BATCH * T, FF = 4096;
constexpr int NH = 8, DH = 128, BLK = 256, NBLK = T / BLK;
constexpr int LH = 8, DQK = 64, DV = 128, LC = 64, NCH = T / LC;
constexpr int NIN = 2 * LH * DQK + 2 * LH * DV + 2 * LH;
constexpr int NIN_G = 3072;
constexpr float RMS_EPS = 1e-6f, SOFTCAP = 15.0f;
constexpr float LOG2E = 1.4426950408889634f;
constexpr float QSCALE = 0.08838834764831845f * LOG2E;
constexpr float NEG_BIG = -1e30f;

constexpr size_t MiB = 1u << 20;
constexpr size_t WS_CTL = 0, CTL_ZERO_BYTES = 1 * MiB;
constexpr size_t WS_USUM = 1 * MiB;
constexpr size_t WS_KMEAN = 2 * MiB;
constexpr size_t WS_G = 3 * MiB;
constexpr size_t WS_XNLO = 160 * MiB;
constexpr size_t WS_MASK = 5 * MiB;
constexpr size_t WS_LIST = 1 * MiB;
constexpr size_t WS_CNT = 5 * MiB + 512 * 1024;
constexpr size_t WS_LSE = 6 * MiB;
constexpr size_t WS_PSEL = 160 * MiB;
constexpr size_t WS_GIF = 6 * MiB;
constexpr size_t WS_SMALL = 7 * MiB;
constexpr size_t WS_W = 8 * MiB;
constexpr size_t WS_XN = 32 * MiB;
constexpr size_t WS_QKV = 64 * MiB;
constexpr size_t WS_DC = 160 * MiB;
constexpr size_t WS_U = 192 * MiB;
constexpr size_t WS_END = 256 * MiB;
constexpr int CW_BAR = 4096;

constexpr int RING_BYTES = 131072;
constexpr int LDSCTL_OFF = RING_BYTES, MISC_OFF = LDSCTL_OFF + 320;
constexpr int LDS_BYTES = 147456;

__device__ __forceinline__ float bperm_f(int srclane, float v) { return __int_as_float(__builtin_amdgcn_ds_bpermute(srclane << 2, __float_as_int(v))); }
__device__ __forceinline__ int bperm_i(int srclane, int v) { return __builtin_amdgcn_ds_bpermute(srclane << 2, v); }
__device__ __forceinline__ float rdlane_f(float v, int l) { return __int_as_float(__builtin_amdgcn_readlane(__float_as_int(v), l)); }
__device__ __forceinline__ float wave_sum(float v, int lane) {
#pragma unroll
    for (int o = 1; o < 64; o <<= 1) v += bperm_f(lane ^ o, v);
    return v;
}
__device__ __forceinline__ float wave_max(float v, int lane) {
#pragma unroll
    for (int o = 1; o < 64; o <<= 1) v = fmaxf(v, bperm_f(lane ^ o, v));
    return v;
}
__device__ __forceinline__ float bf_lo(unsigned w) { return __uint_as_float(w << 16); }
__device__ __forceinline__ float bf_hi(unsigned w) { return __uint_as_float(w & 0xffff0000u); }
__device__ __forceinline__ float bf1(bf16 h) { return __uint_as_float(((unsigned)h) << 16); }

__device__ __forceinline__ void transpose_item(const float* W, int K, int N, int ld, bf16* WT, LAS float* scr, int item, int lane) {
    const int nblk = N / 32, kb = item / nblk, nb = item % nblk, k0 = 64 * kb, n0 = 32 * nb;
#pragma unroll 8
    for (int i = 0; i < 32; ++i) { const int kk = 2 * i + (lane >> 5); scr[kk * 33 + (lane & 31)] = W[(size_t)(k0 + kk) * ld + n0 + (lane & 31)]; }
    LDS_WAIT(); asm volatile("" ::: "memory");
    const int c = lane & 7;
#pragma unroll
    for (int j = 0; j < 4; ++j) { const int n = (lane >> 3) + 8 * j; const LAS float* s = scr + (8 * c) * 33 + n;
        v4u o; o.x = pk2(s[0 * 33], s[1 * 33]); o.y = pk2(s[2 * 33], s[3 * 33]); o.z = pk2(s[4 * 33], s[5 * 33]); o.w = pk2(s[6 * 33], s[7 * 33]);
        *(GAS v4u*)(WT + (size_t)(n0 + n) * K + k0 + 8 * c) = o; }
    LDS_WAIT(); asm volatile("" ::: "memory");
}
__device__ __forceinline__ void convert_weights(const float* wmix_in, int ld_in, const float* wmix_out, const float* wup, const float* wdown, unsigned char* ws, LAS unsigned char* lds, int gw, int NGW, int wave, int lane) {
    LAS float* scr = (LAS float*)(lds + wave * 16384);
    bf16* W_IN = (bf16*)(ws + WS_W); bf16* W_OUT = (bf16*)(ws + WS_W + 6 * MiB); bf16* W_UP = (bf16*)(ws + WS_W + 8 * MiB); bf16* W_DN = (bf16*)(ws + WS_W + 16 * MiB);
    constexpr int I_IN = (D / 64) * (3072 / 32), I_O = (D / 64) * (D / 32), I_UP = (D / 64) * (FF / 32), I_DN = (FF / 64) * (D / 32);
    for (int it = gw; it < I_IN + I_O + I_UP + I_DN; it += NGW) {
        int r = it;
        if (r < I_IN) { transpose_item(wmix_in, D, 3072, ld_in, W_IN, scr, r, lane); continue; } r -= I_IN;
        if (r < I_O) { transpose_item(wmix_out, D, D, D, W_OUT, scr, r, lane); continue; } r -= I_O;
        if (r < I_UP) { transpose_item(wup, D, FF, FF, W_UP, scr, r, lane); continue; } r -= I_UP;
        transpose_item(wdown, FF, D, D, W_DN, scr, r, lane);
    }
}

__device__ __forceinline__ void rms_row(const float* xrow, const float* gain, int lane, f32x4 (&u)[4]) {
    const GAS f32x4* xr = (const GAS f32x4*)xrow + lane; const GAS f32x4* gr = (const GAS f32x4*)gain + lane;
    float s = 0.f;
#pragma unroll
    for (int j = 0; j < 4; ++j) { u[j] = xr[64 * j]; s += (u[j].x * u[j].x + u[j].y * u[j].y) + (u[j].z * u[j].z + u[j].w * u[j].w); }
    const float r = 1.0f / sqrtf(wave_sum(s, lane) * (1.f / D) + RMS_EPS);
#pragma unroll
    for (int j = 0; j < 4; ++j) { const f32x4 g = gr[64 * j]; u[j] = u[j] * r * g; }
}
__device__ __forceinline__ void store_row_bf16(bf16* orow, int lane, const f32x4 (&u)[4]) {
    GAS unsigned long long* o8 = (GAS unsigned long long*)orow + lane;
#pragma unroll
    for (int j = 0; j < 4; ++j) o8[64 * j] = (unsigned long long)pk2(u[j].x, u[j].y) | ((unsigned long long)pk2(u[j].z, u[j].w) << 32);
}

__device__ __forceinline__ unsigned bf_rne(float f) { return f2bf(f); }
__device__ __forceinline__ void store_row_hilo(bf16* hrow, bf16* lrow, int lane, const f32x4 (&u)[4]) {
    GAS unsigned long long* h8 = (GAS unsigned long long*)hrow + lane; GAS unsigned long long* l8 = (GAS unsigned long long*)lrow + lane;
#pragma unroll
    for (int j = 0; j < 4; ++j) {
        const unsigned hx = f2bf(u[j].x), hy = f2bf(u[j].y), hz = f2bf(u[j].z), hw = f2bf(u[j].w);
        const unsigned lx = f2bf(u[j].x - __uint_as_float(hx << 16)), ly = f2bf(u[j].y - __uint_as_float(hy << 16)), lz = f2bf(u[j].z - __uint_as_float(hz << 16)), lw = f2bf(u[j].w - __uint_as_float(hw << 16));
        h8[64 * j] = (unsigned long long)(hx | (hy << 16)) | ((unsigned long long)(hz | (hw << 16)) << 32);
        l8[64 * j] = (unsigned long long)(lx | (ly << 16)) | ((unsigned long long)(lz | (lw << 16)) << 32);
    }
}
__device__ __forceinline__ void phase_p0(const float* x, const float* gain, unsigned char* ws, LAS unsigned char* lds, int wg, int G, int tid, int wave, int lane) {
    bf16* XN = (bf16*)(ws + WS_XN); bf16* XNLO = (bf16*)(ws + WS_XNLO); float* USUM = (float*)(ws + WS_USUM);
    LAS f32x4* red = (LAS f32x4*)lds;
    for (int part = wg; part < M / 64; part += G) {
        f32x4 acc[4];
#pragma unroll
        for (int j = 0; j < 4; ++j) acc[j] = (f32x4){0.f, 0.f, 0.f, 0.f};
        for (int i = 0; i < 8; ++i) {
            const int row = part * 64 + wave * 8 + i; f32x4 u[4];
            rms_row(x + (size_t)row * D, gain, lane, u);
            store_row_hilo(XN + (size_t)row * D, XNLO + (size_t)row * D, lane, u);
#pragma unroll
            for (int j = 0; j < 4; ++j) acc[j] = acc[j] + u[j];
        }
#pragma unroll
        for (int j = 0; j < 4; ++j) red[wave * 256 + 64 * j + lane] = acc[j];
        __syncthreads();
        if (tid < 256) { f32x4 s = red[tid];
#pragma unroll
            for (int w = 1; w < 8; ++w) s = s + red[w * 256 + tid];
            *((GAS f32x4*)(USUM + (size_t)part * 1024) + tid) = s; }
        __syncthreads();
    }
}
__device__ __forceinline__ void phase_kmean(const float* wqkv, unsigned char* ws, int wg, int G, int wave, int lane) {
    const float* USUM = (const float*)(ws + WS_USUM); float* KMEAN = (float*)(ws + WS_KMEAN);
    for (int cg = wg; cg < 256; cg += G) {
        f32x4 w[16];
#pragma unroll
        for (int kk = 0; kk < 16; ++kk) w[kk] = *(const GAS f32x4*)(wqkv + (size_t)(64 * kk + lane) * 3072 + 1024 + 4 * cg);
        for (int bl = 0; bl < 8; ++bl) {
            const int blk = wave * 8 + bl; f32x4 a = (f32x4){0.f, 0.f, 0.f, 0.f};
#pragma unroll
            for (int kk = 0; kk < 16; ++kk) { const int k = 64 * kk + lane; const float* up = USUM + (size_t)(4 * blk) * 1024 + k;
                const float us = (up[0] + up[1024]) + (up[2048] + up[3072]); a = a + w[kk] * us; }
            a.x = wave_sum(a.x, lane); a.y = wave_sum(a.y, lane); a.z = wave_sum(a.z, lane); a.w = wave_sum(a.w, lane);
            if (lane == 0) *(GAS f32x4*)(KMEAN + (size_t)blk * 1024 + 4 * cg) = a * (1.0f / 256.0f);
        }
    }
}
__device__ __forceinline__ void phase_g(const float* wqkv, unsigned char* ws, int wg, int G, int wave, int lane) {
    const float* KMEAN = (const float*)(ws + WS_KMEAN); bf16* GH = (bf16*)(ws + WS_G); bf16* GL = GH + 512 * 1024;
    for (int unit = wg; unit < 256; unit += G) {
        const int h = unit & 7, kg = (unit >> 3) & 15, bh = unit >> 7, k = 64 * kg + lane;
        const float* wq = wqkv + (size_t)k * 3072 + h * 128;
        float acc[4] = {0.f, 0.f, 0.f, 0.f};
        for (int dc = 0; dc < 128; dc += 32) {
            f32x4 wv[8];
#pragma unroll
            for (int i = 0; i < 8; ++i) wv[i] = *(const GAS f32x4*)(wq + dc + 4 * i);
#pragma unroll
            for (int bl = 0; bl < 4; ++bl) { const int blk = bh * 32 + wave * 4 + bl; const float* km = KMEAN + (size_t)blk * 1024 + h * 128 + dc;
#pragma unroll
                for (int i = 0; i < 8; ++i) { const f32x4 kv = *(const GAS f32x4*)(km + 4 * i); acc[bl] += (wv[i].x * kv.x + wv[i].y * kv.y) + (wv[i].z * kv.z + wv[i].w * kv.w); } }
        }
#pragma unroll
        for (int bl = 0; bl < 4; ++bl) { const int blk = bh * 32 + wave * 4 + bl, b = blk >> 5, n = blk & 31; const size_t gi = ((size_t)(b * 256 + h * 32 + n)) * 1024 + k;
            const unsigned gh = f2bf(acc[bl]); GH[gi] = (bf16)gh; GL[gi] = (bf16)f2bf(acc[bl] - __uint_as_float(gh << 16)); }
    }
}
__device__ __forceinline__ void phase_gate(unsigned char* ws, LAS unsigned char* lds, int wg, int G, int wave, int lane) {
    typedef short b8 __attribute__((ext_vector_type(8))); typedef float f16v __attribute__((ext_vector_type(16)));
    const bf16* XH = (const bf16*)(ws + WS_XN); const bf16* XL = (const bf16*)(ws + WS_XNLO); const bf16* GH = (const bf16*)(ws + WS_G); const bf16* GL = GH + 512 * 1024;
    unsigned* MASKT = (unsigned*)(ws + WS_MASK);
    LAS float* gl = (LAS float*)(lds + wave * 8448);
    const int r32 = lane & 31, hi = lane >> 5, h = wave;
    for (int tile = wg; tile < M / 64; tile += G) {
        const int row0 = tile * 64, b = row0 >> 13, s0 = row0 & (T - 1), npast = s0 >> 8;
        if (npast == 0) { MASKT[((size_t)(b * 8 + h)) * T + s0 + lane] = 0u; continue; }
        f16v acc0, acc1;
#pragma unroll
        for (int i = 0; i < 16; ++i) { acc0[i] = 0.f; acc1[i] = 0.f; }
        const bf16* a0h = XH + (size_t)(row0 + r32) * D + 8 * hi; const bf16* a0l = XL + (size_t)(row0 + r32) * D + 8 * hi;
        const bf16* gbh = GH + ((size_t)(b * 256 + h * 32 + r32)) * D + 8 * hi; const bf16* gbl = GL + ((size_t)(b * 256 + h * 32 + r32)) * D + 8 * hi;
#pragma unroll 4
        for (int ks = 0; ks < D / 16; ++ks) {
            const int k = 16 * ks;
            const b8 A0h = *(const GAS b8*)(a0h + k), A0l = *(const GAS b8*)(a0l + k), A1h = *(const GAS b8*)(a0h + 32 * D + k), A1l = *(const GAS b8*)(a0l + 32 * D + k);
            const b8 Bh = *(const GAS b8*)(gbh + k), Bl = *(const GAS b8*)(gbl + k);
            acc0 = __builtin_amdgcn_mfma_f32_32x32x16_bf16(A0h, Bh, acc0, 0, 0, 0); acc1 = __builtin_amdgcn_mfma_f32_32x32x16_bf16(A1h, Bh, acc1, 0, 0, 0);
            acc0 = __builtin_amdgcn_mfma_f32_32x32x16_bf16(A0l, Bh, acc0, 0, 0, 0); acc1 = __builtin_amdgcn_mfma_f32_32x32x16_bf16(A1l, Bh, acc1, 0, 0, 0);
            acc0 = __builtin_amdgcn_mfma_f32_32x32x16_bf16(A0h, Bl, acc0, 0, 0, 0); acc1 = __builtin_amdgcn_mfma_f32_32x32x16_bf16(A1h, Bl, acc1, 0, 0, 0);
        }
#pragma unroll
        for (int i = 0; i < 16; ++i) { const int r = (i & 3) + 8 * (i >> 2) + 4 * hi; gl[r * 33 + r32] = acc0[i]; gl[(32 + r) * 33 + r32] = acc1[i]; }
        LDS_WAIT(); asm volatile("" ::: "memory");
        float v0 = -INFINITY, v1 = -INFINITY, v2 = -INFINITY; int i0 = 0, i1 = 0, i2 = 0;
        for (int n = 0; n < npast; ++n) {
            const float a = gl[lane * 33 + n];
            const bool c0 = a > v0, c1 = a > v1, c2 = a > v2;
            v2 = c1 ? v1 : (c2 ? a : v2); i2 = c1 ? i1 : (c2 ? n : i2);
            v1 = c0 ? v0 : (c1 ? a : v1); i1 = c0 ? i0 : (c1 ? n : i1);
            v0 = c0 ? a : v0; i0 = c0 ? n : i0;
        }
        unsigned mk = 1u << i0; if (npast > 1) mk |= 1u << i1; if (npast > 2) mk |= 1u << i2;
        MASKT[((size_t)(b * 8 + h)) * T + s0 + lane] = mk;
        LDS_WAIT(); asm volatile("" ::: "memory");
    }
}
__device__ __forceinline__ int list_base(int bh, int j) { return bh * 126976 + 256 * (31 * j - (j * (j - 1)) / 2); }
__device__ __forceinline__ void phase_lists(unsigned char* ws, int gw, int NGW, int lane) {
    const unsigned* MASKT = (const unsigned*)(ws + WS_MASK); unsigned short* LIST = (unsigned short*)(ws + WS_LIST); int* CNT = (int*)(ws + WS_CNT);
    for (int li = gw; li < 16 * 31; li += NGW) {
        const int bh = li / 31, j = li - bh * 31;
        const unsigned* mk = MASKT + (size_t)bh * T; unsigned short* dst = LIST + list_base(bh, j); int base = 0;
        for (int s0 = (j + 1) * BLK; s0 < T; s0 += 256) {
            const v4u m4 = *(const GAS v4u*)(mk + s0 + 4 * lane);
            const int f0 = (m4.x >> j) & 1, f1 = (m4.y >> j) & 1, f2 = (m4.z >> j) & 1, f3 = (m4.w >> j) & 1, c = f0 + f1 + f2 + f3;
            int inc = c;
#pragma unroll
            for (int o = 1; o < 64; o <<= 1) { const int t = bperm_i(lane - o, inc); if (lane >= o) inc += t; }
            int pos = base + inc - c; const int s = s0 + 4 * lane;
            if (f0) dst[pos++] = (unsigned short)s;
            if (f1) dst[pos++] = (unsigned short)(s + 1);
            if (f2) dst[pos++] = (unsigned short)(s + 2);
            if (f3) dst[pos++] = (unsigned short)(s + 3);
            base += __builtin_amdgcn_readlane(inc, 63);
        }
        if (lane == 0) CNT[li] = base;
    }
}
__device__ __forceinline__ void phase_attn(unsigned char* ws, char* lds, int wg, int G, int tid) {
    const bf16* Q = (const bf16*)(ws + WS_QKV); const bf16* K = Q + (size_t)M * D; const bf16* V = K + (size_t)M * D;
    const unsigned* MASKT = (const unsigned*)(ws + WS_MASK); const unsigned short* LIST = (const unsigned short*)(ws + WS_LIST); const int* CNT = (const int*)(ws + WS_CNT);
    bf16* POWN = (bf16*)(ws + WS_XN); bf16* PSEL = (bf16*)(ws + WS_PSEL); float* LSE = (float*)(ws + WS_LSE);
    int* pre = (int*)(lds + moba::LDS_ATTN);
    const int lane = tid & 63, wave = tid >> 6, r32 = lane & 31, hi = lane >> 5;
    {
        int c = (tid < 496) ? ((CNT[tid] + 255) >> 8) : 0;
#pragma unroll
        for (int o = 1; o < 64; o <<= 1) { const int t = bperm_i(lane - o, c); if (lane >= o) c += t; }
        int* wtot = pre + 512;
        if (lane == 63) wtot[wave] = c;
        __syncthreads();
        int add = 0;
#pragma unroll
        for (int w = 0; w < 8; ++w) if (w < wave) add += wtot[w];
        pre[tid] = c + add;
        __syncthreads();
    }
    const int total = __builtin_amdgcn_readfirstlane(512 + pre[495]);
    for (int u = wg; u < total; u += G) {
        int bh, jb, tile = 0, cnt = 256, own;
        if (u < 512) { bh = u >> 5; jb = u & 31; own = 1; }
        else {
            const int v = u - 512; int lo = 0, hi_ = 495;
            while (lo < hi_) { const int mid = (lo + hi_) >> 1; if (__builtin_amdgcn_readfirstlane(pre[mid]) > v) hi_ = mid; else lo = mid + 1; }
            const int li = lo; tile = v - (li ? __builtin_amdgcn_readfirstlane(pre[li - 1]) : 0); bh = li / 31; jb = li - bh * 31; own = 0;
            cnt = __builtin_amdgcn_readfirstlane(CNT[li]);
        }
        const int b = bh >> 3, h = bh & 7;
        const float sl2 = exp2f(-(float)(h + 1)) * LOG2E;
        const int idx = tile * 256 + wave * 32 + r32; const bool valid = idx < cnt;
        int sq, slot = 0;
        if (own) sq = jb * BLK + idx;
        else { sq = (int)LIST[list_base(bh, jb) + (valid ? idx : cnt - 1)]; slot = __builtin_popcount(MASKT[(size_t)bh * T + sq] & ((1u << jb) - 1u)); }
        const size_t m = (size_t)b * T + sq;
        const unsigned outoff = own ? (unsigned)(m * D + h * DH) : (unsigned)(((m * 8 + h) * 3 + slot) * DH);
        const size_t kv0 = ((size_t)b * T + jb * BLK) * D + h * DH;
        moba::attn_unit(Q + m * D + h * DH + hi * 8, K + kv0, V + kv0, -sl2 * (float)(sq - jb * BLK), own ? (wave * 32 + r32) : (1 << 20), sl2, valid, outoff, own ? POWN : PSEL,
                        LSE + (m * 8 + h) * 4 + (own ? 0 : 1 + slot), lds, tid);
    }
}
__device__ __forceinline__ void phase_combine(unsigned char* ws, int gtid, int NTH) {
    const unsigned* MASKT = (const unsigned*)(ws + WS_MASK); bf16* POWN = (bf16*)(ws + WS_XN); const bf16* PSEL = (const bf16*)(ws + WS_PSEL); const float* LSE = (const float*)(ws + WS_LSE);
    for (int e = gtid; e < M * NH * 16; e += NTH) {
        const int dg = e & 15, mh = e >> 4, h = mh & 7, m = mh >> 3, b = m >> 13, s = m & (T - 1);
        const int nsel = __builtin_popcount(MASKT[((size_t)(b * 8 + h)) * T + s]);
        const f32x4 l4 = *(const GAS f32x4*)(LSE + (size_t)mh * 4);
        float ls[4] = {l4.x, nsel > 0 ? l4.y : -INFINITY, nsel > 1 ? l4.z : -INFINITY, nsel > 2 ? l4.w : -INFINITY};
        const float mx = fmaxf(fmaxf(ls[0], ls[1]), fmaxf(ls[2], ls[3]));
        float w[4], den = 0.f;
#pragma unroll
        for (int p = 0; p < 4; ++p) { w[p] = exp2f(ls[p] - mx); den += w[p]; }
        const float inv = 1.0f / den;
        GAS v4u* own = (GAS v4u*)(POWN + (size_t)m * D + h * DH + dg * 8);
        float acc[8];
        { const v4u x = *own; const float ww = w[0] * inv;
          acc[0] = ww * bf_lo(x.x); acc[1] = ww * bf_hi(x.x); acc[2] = ww * bf_lo(x.y); acc[3] = ww * bf_hi(x.y); acc[4] = ww * bf_lo(x.z); acc[5] = ww * bf_hi(x.z); acc[6] = ww * bf_lo(x.w); acc[7] = ww * bf_hi(x.w); }
#pragma unroll
        for (int p = 1; p < 4; ++p) if (p <= nsel) { const v4u x = *(const GAS v4u*)(PSEL + ((size_t)mh * 3 + (p - 1)) * DH + dg * 8); const float ww = w[p] * inv;
          acc[0] += ww * bf_lo(x.x); acc[1] += ww * bf_hi(x.x); acc[2] += ww * bf_lo(x.y); acc[3] += ww * bf_hi(x.y); acc[4] += ww * bf_lo(x.z); acc[5] += ww * bf_hi(x.z); acc[6] += ww * bf_lo(x.w); acc[7] += ww * bf_hi(x.w); }
        v4u o; o.x = pk2(acc[0], acc[1]); o.y = pk2(acc[2], acc[3]); o.z = pk2(acc[4], acc[5]); o.w = pk2(acc[6], acc[7]);
        *own = o;
    }
}
template <bool SECOND, bool GATES>
__device__ __forceinline__ void norm_rows(const float* U, const float* hin, float* hout, const float* gpost, const float* gpre, bf16* XN, const LAS float* wg, const float* bg, float* GIF, int gw, int NGW, int lane) {
    for (int m = gw; m < M; m += NGW) {
        f32x4 u[4]; rms_row(U + (size_t)m * D, gpost, lane, u);
        const GAS f32x4* hr = (const GAS f32x4*)(hin + (size_t)m * D) + lane; GAS f32x4* ho = (GAS f32x4*)(hout + (size_t)m * D) + lane;
        float s = 0.f;
#pragma unroll
        for (int j = 0; j < 4; ++j) { u[j] = u[j] + hr[64 * j]; ho[64 * j] = u[j]; s += (u[j].x * u[j].x + u[j].y * u[j].y) + (u[j].z * u[j].z + u[j].w * u[j].w); }
        if (SECOND) {
            const float r = 1.0f / sqrtf(wave_sum(s, lane) * (1.f / D) + RMS_EPS); const GAS f32x4* gr = (const GAS f32x4*)gpre + lane;
#pragma unroll
            for (int j = 0; j < 4; ++j) u[j] = u[j] * r * gr[64 * j];
            store_row_bf16(XN + (size_t)m * D, lane, u);
            if (GATES) {
                float mine = 0.f;
#pragma unroll 1
                for (int g = 0; g < 16; ++g) { float a = 0.f;
#pragma unroll
                    for (int j = 0; j < 4; ++j) { const f32x4 w = *((const LAS f32x4*)(wg + g * 1024) + 64 * j + lane); a += (u[j].x * w.x + u[j].y * w.y) + (u[j].z * w.z + u[j].w * w.w); }
                    a = wave_sum(a, lane); if (lane == g) mine = a; }
                if (lane < 16) { const float z = SOFTCAP * tanhf((mine + bg[lane]) * (1.0f / SOFTCAP));
                    GIF[(size_t)m * 16 + lane] = (lane < 8) ? z : -log1pf(expf(-z)); }
            }
        }
    }
}
__device__ __forceinline__ float scan_add(float v, int lane) {
#pragma unroll
    for (int o = 1; o < 64; o <<= 1) { const float t = bperm_f(lane - o, v); if (lane >= o) v += t; }
    return v;
}
__device__ __forceinline__ float scan_max(float v, int lane) {
#pragma unroll
    for (int o = 1; o < 64; o <<= 1) { const float t = bperm_f(lane - o, v); if (lane >= o) v = fmaxf(v, t); }
    return v;
}
__device__ __forceinline__ void phase_mlstm_a(unsigned char* ws, int gw, int NGW, int lane) {
    const bf16* QK = (const bf16*)(ws + WS_QKV); const float* GIF = (const float*)(ws + WS_GIF);
    float* DC = (float*)(ws + WS_DC); float* BEND = (float*)(ws + WS_SMALL); float* MLOC = BEND + 2048; float* DN = BEND + 3 * 2048;
    float* BCUM = (float*)(ws + WS_USUM); float* GMX = BCUM + (size_t)M * 8;
    for (int unit = gw; unit < 16 * NCH; unit += NGW) {
        const int bh = unit >> 7, c = unit & 127, b = bh >> 3, h = bh & 7, tok0 = b * T + c * LC;
        const float lf = GIF[(size_t)(tok0 + lane) * 16 + 8 + h], li = GIF[(size_t)(tok0 + lane) * 16 + h];
        const float bc = scan_add(lf, lane), bend = rdlane_f(bc, 63), lw = bend - bc + li, mloc = wave_max(lw, lane), w = expf(lw - mloc);
        BCUM[(size_t)(tok0 + lane) * 8 + h] = bc; GMX[(size_t)(tok0 + lane) * 8 + h] = scan_max(li - bc, lane);
        float acc[128];
#pragma unroll
        for (int v = 0; v < 128; ++v) acc[v] = 0.f;
        float dn = 0.f;
#pragma unroll 1
        for (int s = 0; s < LC; ++s) {
            const float wsv = rdlane_f(w, s);
            const bf16* row = QK + (size_t)(tok0 + s) * NIN_G;
            const float kw = wsv * bf1(row[512 + h * DQK + lane]); dn += kw;
            const GAS v4u* vr = (const GAS v4u*)(row + 1024 + h * DV);
#pragma unroll
            for (int i = 0; i < 16; ++i) { const v4u vw = vr[i];
                acc[8 * i + 0] += kw * bf_lo(vw.x); acc[8 * i + 1] += kw * bf_hi(vw.x); acc[8 * i + 2] += kw * bf_lo(vw.y); acc[8 * i + 3] += kw * bf_hi(vw.y);
                acc[8 * i + 4] += kw * bf_lo(vw.z); acc[8 * i + 5] += kw * bf_hi(vw.z); acc[8 * i + 6] += kw * bf_lo(vw.w); acc[8 * i + 7] += kw * bf_hi(vw.w);
                if (i == 7) asm volatile("" ::: "memory"); }
        }
        GAS f32x4* dst = (GAS f32x4*)(DC + ((size_t)unit * 64 + lane) * 128);
#pragma unroll
        for (int i = 0; i < 32; ++i) dst[i] = (f32x4){acc[4 * i], acc[4 * i + 1], acc[4 * i + 2], acc[4 * i + 3]};
        DN[(size_t)unit * 64 + lane] = dn;
        if (lane == 0) { BEND[unit] = bend; MLOC[unit] = mloc; }
    }
}
__device__ __forceinline__ void phase_mlstm_b(unsigned char* ws, int gtid, int NT) {
    float* DC = (float*)(ws + WS_DC); float* BEND = (float*)(ws + WS_SMALL); float* MLOC = BEND + 2048; float* MST = BEND + 2 * 2048; float* DN = BEND + 3 * 2048;
    for (int e = gtid; e < 16 * 8192 + 16 * 64; e += NT) {
        int bh; float* base; int stride; bool wm = false;
        if (e < 16 * 8192) { bh = e >> 13; base = DC + (size_t)bh * 128 * 8192 + (e & 8191); stride = 8192; }
        else { const int e2 = e - 16 * 8192; bh = e2 >> 6; base = DN + (size_t)bh * 128 * 64 + (e2 & 63); stride = 64; wm = (e2 & 63) == 0; }
        float mcur = 0.f, st = 0.f;
        for (int c0 = 0; c0 < NCH; c0 += 8) {
            float xv[8], be[8], ml[8];
#pragma unroll
            for (int i = 0; i < 8; ++i) { xv[i] = base[(size_t)(c0 + i) * stride]; be[i] = BEND[bh * 128 + c0 + i]; ml[i] = MLOC[bh * 128 + c0 + i]; }
#pragma unroll
            for (int i = 0; i < 8; ++i) {
                base[(size_t)(c0 + i) * stride] = st; if (wm) MST[bh * 128 + c0 + i] = mcur;
                const float mn = fmaxf(be[i] + mcur, ml[i]);
                st = expf(be[i] + mcur - mn) * st + expf(ml[i] - mn) * xv[i]; mcur = mn;
            }
        }
    }
}
__device__ __forceinline__ void phase_mlstm_c(const float* norm_h, unsigned char* ws, LAS unsigned char* lds, int gw, int NGW, int wave, int lane) {
    const bf16* QK = (const bf16*)(ws + WS_QKV); const float* GIF = (const float*)(ws + WS_GIF);
    const float* DC = (const float*)(ws + WS_DC); const float* BEND = (const float*)(ws + WS_SMALL); const float* MST = BEND + 2 * 2048; const float* DN = BEND + 3 * 2048;
    bf16* Y = (bf16*)(ws + WS_XN); const float* BCUM = (const float*)(ws + WS_USUM); const float* GMX = BCUM + (size_t)M * 8;
    LAS float* sl = (LAS float*)(lds + wave * 16384);
    for (int unit = gw; unit < 16 * NCH; unit += NGW) {
        const int bh = unit >> 7, c = unit & 127, b = bh >> 3, h = bh & 7, tok0 = b * T + c * LC, tok = tok0 + lane;
        const float li = GIF[(size_t)tok * 16 + h];
        const float bc = BCUM[(size_t)tok * 8 + h], g = li - bc, mxp = GMX[(size_t)tok * 8 + h], mc = MST[unit];
        const float mmax = fmaxf(mc, mxp), winter = expf(mc - mmax);
        float den = 0.f;
        {
            float q[64];
            const GAS v4u* qr = (const GAS v4u*)(QK + (size_t)tok * NIN_G + h * DQK);
#pragma unroll
            for (int i = 0; i < 8; ++i) { const v4u w = qr[i]; q[8 * i] = bf_lo(w.x); q[8 * i + 1] = bf_hi(w.x); q[8 * i + 2] = bf_lo(w.y); q[8 * i + 3] = bf_hi(w.y);
                q[8 * i + 4] = bf_lo(w.z); q[8 * i + 5] = bf_hi(w.z); q[8 * i + 6] = bf_lo(w.w); q[8 * i + 7] = bf_hi(w.w); }
    #pragma unroll 1
        for (int s = 0; s < LC; ++s) {
                const GAS v4u* kr = (const GAS v4u*)(QK + (size_t)(tok0 + s) * NIN_G + 512 + h * DQK); float dot = 0.f;
#pragma unroll
                for (int i = 0; i < 8; ++i) { const v4u kw = kr[i];
                    dot += (q[8 * i] * bf_lo(kw.x) + q[8 * i + 1] * bf_hi(kw.x)) + (q[8 * i + 2] * bf_lo(kw.y) + q[8 * i + 3] * bf_hi(kw.y)) + (q[8 * i + 4] * bf_lo(kw.z) + q[8 * i + 5] * bf_hi(kw.z)) + (q[8 * i + 6] * bf_lo(kw.w) + q[8 * i + 7] * bf_hi(kw.w)); }
                const float gs = rdlane_f(g, s); const float sv = (s <= lane) ? dot * expf(gs - mmax) : 0.f; den += sv;
                sl[s * 64 + lane] = sv;
            }
        }
        LDS_WAIT(); asm volatile("" ::: "memory");
        float acc[128];
#pragma unroll
        for (int v = 0; v < 128; ++v) acc[v] = 0.f;
#pragma unroll 1
        for (int s = 0; s < LC; ++s) {
            const float sv = sl[s * 64 + lane];
            const GAS v4u* vr = (const GAS v4u*)(QK + (size_t)(tok0 + s) * NIN_G + 1024 + h * DV);
#pragma unroll
            for (int i = 0; i < 16; ++i) { const v4u vw = vr[i];
                acc[8 * i + 0] += sv * bf_lo(vw.x); acc[8 * i + 1] += sv * bf_hi(vw.x); acc[8 * i + 2] += sv * bf_lo(vw.y); acc[8 * i + 3] += sv * bf_hi(vw.y);
                acc[8 * i + 4] += sv * bf_lo(vw.z); acc[8 * i + 5] += sv * bf_hi(vw.z); acc[8 * i + 6] += sv * bf_lo(vw.w); acc[8 * i + 7] += sv * bf_hi(vw.w);
                if (i == 7) asm volatile("" ::: "memory"); }
        }
        float qn = 0.f;
#pragma unroll 1
        for (int d = 0; d < DQK; ++d) {
            const float qd = bf1(QK[(size_t)tok * NIN_G + h * DQK + d]); qn += qd * DN[(size_t)unit * 64 + d]; const float qw = qd * winter;
            const GAS f32x4* cr = (const GAS f32x4*)(DC + ((size_t)unit * 64 + d) * 128);
#pragma unroll
            for (int i = 0; i < 32; ++i) { const f32x4 cv = cr[i]; acc[4 * i] += qw * cv.x; acc[4 * i + 1] += qw * cv.y; acc[4 * i + 2] += qw * cv.z; acc[4 * i + 3] += qw * cv.w;
                if ((i & 7) == 7) asm volatile("" ::: "memory"); }
        }
        den = winter * qn + den;
        const float inv = 1.0f / fmaxf(fabsf(den), expf(-(bc + mmax)));
        float ssq = 0.f;
#pragma unroll
        for (int v = 0; v < 128; ++v) { acc[v] *= inv; ssq += acc[v] * acc[v]; }
        const float rn = 1.0f / sqrtf(ssq * (1.0f / DV) + RMS_EPS);
        const GAS v4u* orow = (const GAS v4u*)(QK + (size_t)tok * NIN_G + 2048 + h * DV); GAS v4u* yrow = (GAS v4u*)(Y + (size_t)tok * D + h * DV);
        const float* nh = norm_h + h * DV;
#pragma unroll
        for (int i = 0; i < 16; ++i) { const v4u ow = orow[i]; float o[8] = {bf_lo(ow.x), bf_hi(ow.x), bf_lo(ow.y), bf_hi(ow.y), bf_lo(ow.z), bf_hi(ow.z), bf_lo(ow.w), bf_hi(ow.w)}; float y[8];
#pragma unroll
            for (int e = 0; e < 8; ++e) y[e] = acc[8 * i + e] * rn * nh[8 * i + e] * (1.0f / (1.0f + expf(-o[e])));
            v4u yw; yw.x = pk2(y[0], y[1]); yw.y = pk2(y[2], y[3]); yw.z = pk2(y[4], y[5]); yw.w = pk2(y[6], y[7]); yrow[i] = yw;
            if ((i & 3) == 3) asm volatile("" ::: "memory"); }
        LDS_WAIT(); asm volatile("" ::: "memory");
    }
}

struct Args { const float* in[13]; float* out; unsigned char* ws; };
__global__ void __launch_bounds__(NTHR, 2) fwd_kernel(Args args) {
    extern __shared__ __attribute__((aligned(16))) unsigned char lds_raw[];
    LAS unsigned char* lds = (LAS unsigned char*)lds_raw;
    volatile LAS unsigned* MISC = (volatile LAS unsigned*)(lds + MISC_OFF);
    const int wave = __builtin_amdgcn_readfirstlane((int)threadIdx.x >> 6);
    const int G = gridDim.x, wg = blockIdx.x;
#define FRESH int lane_ = (int)__lane_id(); asm volatile("" : "+v"(lane_)); const int lane = lane_; const int tid = wave * 64 + lane; (void)tid;
    const int gw = wg * NWAVES + wave, NGW = G * NWAVES;
    unsigned char* ws = args.ws;
    gu32* ctl = (gu32*)(ws + WS_CTL);
    { FRESH for (int u = tid; u < (LDS_BYTES - LDSCTL_OFF) / 4; u += NTHR) ((LAS unsigned*)(lds + LDSCTL_OFF))[u] = 0u; }
    __syncthreads();
    XcdBarrier bar = xcd_barrier_post((unsigned*)(ctl + CW_BAR), MISC + 8);
#define GRID_BAR() do { FRESH xcd_barrier(bar, tid == 0); } while (0)
    const float* x = args.in[0]; const float* g_mix_pre = args.in[1]; const float* g_mix_post = args.in[2]; const float* g_ffn_pre = args.in[3]; const float* g_ffn_post = args.in[4];
    const float* w_up = args.in[5]; const float* w_down = args.in[6]; const float* w_qkv = args.in[7]; const float* w_o = args.in[8];
    const float* w_in = args.in[9]; const float* b_gates = args.in[10]; const float* norm_h = args.in[11]; const float* w_out = args.in[12];
    float* out = args.out;
    bf16* W_IN = (bf16*)(ws + WS_W); bf16* W_OUT = (bf16*)(ws + WS_W + 6 * MiB); bf16* W_UP = (bf16*)(ws + WS_W + 8 * MiB); bf16* W_DN = (bf16*)(ws + WS_W + 16 * MiB);
    bf16* XN = (bf16*)(ws + WS_XN); bf16* QKV = (bf16*)(ws + WS_QKV); float* U = (float*)(ws + WS_U);

    { FRESH convert_weights(w_qkv, 3072, w_o, w_up, w_down, ws, lds, gw, NGW, wave, lane); }
    __syncthreads();
    { FRESH phase_p0(x, g_mix_pre, ws, lds, wg, G, tid, wave, lane); }
    GRID_BAR();
    {
        pg8::Gemm g{XN, W_IN, M, 3 * D, D}; pg8::StaticOrder S; S.init(M, 3 * D, G, wg);
        pg8::EpiBf16<0> E{QKV, D, D, (size_t)M * D, 0, D, QSCALE};
        FRESH pg8::gemm_phase<pg8::EpiBf16<0>, pg8::StaticOrder, true, true>(lds, g, S, E, tid);
    }
    { FRESH phase_kmean(w_qkv, ws, wg, G, wave, lane); }
    GRID_BAR();
    { FRESH phase_g(w_qkv, ws, wg, G, wave, lane); }
    GRID_BAR();
    { FRESH phase_gate(ws, lds, wg, G, wave, lane); }
    GRID_BAR();
    { FRESH phase_lists(ws, gw, NGW, lane); }
    GRID_BAR();
    { FRESH phase_attn(ws, (char*)lds_raw, wg, G, tid); }
    GRID_BAR();
    { FRESH phase_combine(ws, wg * NTHR + tid, G * NTHR); }
    GRID_BAR();
    {
        pg8::Gemm g{XN, W_OUT, M, D, D}; pg8::StaticOrder S; S.init(M, D, G, wg);
        pg8::EpiF32 E{U, D};
        FRESH pg8::gemm_phase<pg8::EpiF32, pg8::StaticOrder, true, true>(lds, g, S, E, tid);
    }
    GRID_BAR();
    { FRESH norm_rows<true, false>(U, x, out, g_mix_post, g_ffn_pre, XN, nullptr, nullptr, nullptr, gw, NGW, lane); }
    GRID_BAR();
    {
        pg8::Gemm g{XN, W_UP, M, FF, D}; pg8::StaticOrder S; S.init(M, FF, G, wg);
        pg8::EpiBf16<2> E{QKV, FF, 0, 0, 0, 0, 1.f};
        FRESH pg8::gemm_phase<pg8::EpiBf16<2>, pg8::StaticOrder, true, true>(lds, g, S, E, tid);
    }
    GRID_BAR();
    {
        pg8::Gemm g{QKV, W_DN, M, D, FF}; pg8::StaticOrder S; S.init(M, D, G, wg);
        pg8::EpiF32 E{U, D};
        FRESH pg8::gemm_phase<pg8::EpiF32, pg8::StaticOrder, true, true>(lds, g, S, E, tid);
    }
    GRID_BAR();
    { FRESH convert_weights(w_in, NIN, w_out, w_up + (size_t)D * FF, w_down + (size_t)D * FF, ws, lds, gw, NGW, wave, lane); }
    __syncthreads();
    {
        LAS float* wgl = (LAS float*)lds;
        { FRESH for (int e = tid; e < 16 * 1024; e += NTHR) { const int k = e >> 4, gg = e & 15; wgl[gg * 1024 + k] = w_in[(size_t)k * NIN + NIN_G + gg]; } }
        __syncthreads();
        { FRESH norm_rows<true, true>(U, out, out, g_ffn_post, g_mix_pre + D, XN, wgl, b_gates, (float*)(ws + WS_GIF), gw, NGW, lane); }
    }
    GRID_BAR();
    {
        pg8::Gemm g{XN, W_IN, M, NIN_G, D}; pg8::StaticOrder S; S.init(M, NIN_G, G, wg);
        pg8::EpiBf16<0> E{QKV, NIN_G, 0, 0, 512, 1024, 0.125f};
        FRESH pg8::gemm_phase<pg8::EpiBf16<0>, pg8::StaticOrder, true, true>(lds, g, S, E, tid);
    }
    GRID_BAR();
    { FRESH phase_mlstm_a(ws, gw, NGW, lane); }
    GRID_BAR();
    { FRESH phase_mlstm_b(ws, wg * NTHR + tid, G * NTHR); }
    GRID_BAR();
    { FRESH phase_mlstm_c(norm_h, ws, lds, gw, NGW, wave, lane); }
    GRID_BAR();
    {
        pg8::Gemm g{XN, W_OUT, M, D, D}; pg8::StaticOrder S; S.init(M, D, G, wg);
        pg8::EpiF32 E{U, D};
        FRESH pg8::gemm_phase<pg8::EpiF32, pg8::StaticOrder, true, true>(lds, g, S, E, tid);
    }
    GRID_BAR();
    { FRESH norm_rows<true, false>(U, out, out, g_mix_post + D, g_ffn_pre + D, XN, nullptr, nullptr, nullptr, gw, NGW, lane); }
    GRID_BAR();
    {
        pg8::Gemm g{XN, W_UP, M, FF, D}; pg8::StaticOrder S; S.init(M, FF, G, wg);
        pg8::EpiBf16<2> E{QKV, FF, 0, 0, 0, 0, 1.f};
        FRESH pg8::gemm_phase<pg8::EpiBf16<2>, pg8::StaticOrder, true, true>(lds, g, S, E, tid);
    }
    GRID_BAR();
    {
        pg8::Gemm g{QKV, W_DN, M, D, FF}; pg8::StaticOrder S; S.init(M, D, G, wg);
        pg8::EpiF32 E{U, D};
        FRESH pg8::gemm_phase<pg8::EpiF32, pg8::StaticOrder, true, true>(lds, g, S, E, tid);
    }
    GRID_BAR();
    { FRESH norm_rows<false, false>(U, out, out, g_ffn_post + D, nullptr, nullptr, nullptr, nullptr, nullptr, gw, NGW, lane); }
}

extern "C" void kernel_launch(void* const* d_in, const int* in_sizes, int n_in, void* d_out, int out_size, void* d_ws, size_t ws_size, hipStream_t stream) {
    static int grid = 0;
    if (grid == 0) {
        if (n_in != 13 || in_sizes[0] != M * D || out_size != M * D || ws_size < WS_END) { fprintf(stderr, "kernel_launch: unexpected shapes (n_in %d in0 %d out %d ws %zu)\n", n_in, n_in > 0 ? in_sizes[0] : -1, out_size, ws_size); grid = -1; return; }
        int dev = 0, cus = 0;
        if (hipGetDevice(&dev) != hipSuccess || hipDeviceGetAttribute(&cus, hipDeviceAttributeMultiprocessorCount, dev) != hipSuccess) { grid = -1; return; }
        if (hipFuncSetAttribute((const void*)fwd_kernel, hipFuncAttributeMaxDynamicSharedMemorySize, LDS_BYTES) != hipSuccess) { fprintf(stderr, "kernel_launch: hipFuncSetAttribute failed\n"); grid = -1; return; }
        int per_cu = 0;
        if (hipOccupancyMaxActiveBlocksPerMultiprocessor(&per_cu, (const void*)fwd_kernel, NTHR, LDS_BYTES) != hipSuccess || per_cu < 1) fprintf(stderr, "kernel_launch: occupancy query reports %d\n", per_cu);
        (void)hipGetLastError();
        grid = cus;
    }
    if (grid < 0) return;
    if (hipMemsetAsync((char*)d_ws + WS_CTL, 0, CTL_ZERO_BYTES, stream) != hipSuccess) return;
    Args a{};
    for (int i = 0; i < 13; ++i) a.in[i] = (const float*)d_in[i];
    a.out = (float*)d_out; a.ws = (unsigned char*)d_ws;
    hipLaunchKernelGGL(fwd_kernel, dim3(grid), dim3(NTHR), LDS_BYTES, stream, a);
}
```

```cpp
#include <hip/hip_runtime.h>
#include <cstdio>
#include <cstdint>
#include <cmath>
namespace pg8 {
#define PG8_LAS __attribute__((address_space(3)))
typedef unsigned short bf16_t;
typedef short bf16x8 __attribute__((ext_vector_type(8)));
typedef float f32x4 __attribute__((ext_vector_type(4)));
typedef unsigned u32x4 __attribute__((ext_vector_type(4)));
constexpr int BM = 256, BK = 64, HALF = 128, HTB = HALF * BK * 2  , STAGE_BYTES = 8 * HTB, NXCD = 8, WGM = 8;

__host__ __device__ __forceinline__ int lds_byte(int r, int c) { const int st = (r >> 4) * 2 + (c >> 5), rr = r & 15, cc = c & 31, ob = rr * 64 + cc * 2; return st * 1024 + (ob ^ (((ob >> 9) & 1) << 5)); }
__host__ __device__ __forceinline__ void stage_rc(int b, int& R, int& C) { const int st = b / 1024, sb = b % 1024, swz = sb ^ (((sb >> 9) & 1) << 5); R = (st >> 1) * 16 + swz / 64; C = (st & 1) * 32 + (swz % 64) / 2; }
__host__ __device__ __forceinline__ int perm32(int rho) { const int n = rho >> 4, i = rho & 15; return 8 * (i >> 2) + 4 * n + (i & 3); }

struct Unit { int pm, pn; };
struct Gemm { const bf16_t* A; const bf16_t* Bt; int M, N, K; };

struct StaticOrder {
    int nM, nN, nwg, G, c;
    __host__ __device__ void init(int M, int N, int G_, int c_) { nM = M / BM; nN = N / BM; nwg = nM * nN; G = G_; c = c_; }
    __host__ __device__ bool next(int i, Unit& u) const {
        const long L = (long)i * G + c; if (L >= nwg) return false;
        int wgid = (int)L; { const int q = nwg / NXCD, r = nwg % NXCD, xcd = wgid % NXCD, off = wgid / NXCD; wgid = (xcd < r ? xcd * (q + 1) : r * (q + 1) + (xcd - r) * q) + off; }
        const int nig = WGM * nN, gid = wgid / nig, fm = gid * WGM, gsz = (nM - fm) < WGM ? (nM - fm) : WGM;
        u.pm = fm + ((wgid % nig) % gsz); u.pn = (wgid % nig) / gsz; return true;
    }
    __device__ __forceinline__ void a_ready(const Unit&) const {}
    __device__ __forceinline__ void done(const Unit&) const {}
};

__device__ __forceinline__ unsigned cvt_pk_bf16(float lo, float hi) { unsigned r; asm volatile("v_cvt_pk_bf16_f32 %0, %1, %2" : "=v"(r) : "v"(lo), "v"(hi)); return r; }
typedef float f32x2 __attribute__((ext_vector_type(2)));
template <int ACT> struct EpiBf16 {
    static constexpr bool PERM = true, AFTER_DRAIN = false;
    bf16_t* O; int ldc; int split_cols; size_t split_stride; int sc_lo, sc_hi; float scale;
    __device__ __forceinline__ void operator()(const f32x4 (&acc)[2][2][4][2], const Unit& u, int wr, int wc, int fr, int fq) const {
        const int row0 = u.pm * BM + wr * 64 + fr; int colt = u.pn * BM; bf16_t* base = O;
        const float sc = (colt >= sc_lo && colt < sc_hi) ? scale : 1.f;
        if (split_cols) { const int t = colt / split_cols; base += (size_t)t * split_stride; colt -= t * split_cols; }
        const int col0 = colt + wc * 32 + 8 * fq;
#pragma unroll
        for (int ai = 0; ai < 2; ++ai)
#pragma unroll
            for (int m = 0; m < 4; ++m) { bf16_t* rowp = base + (size_t)(row0 + ai * HALF + m * 16) * ldc + col0;
#pragma unroll
                for (int bj = 0; bj < 2; ++bj) { f32x4 v0 = acc[ai][bj][m][0], v1 = acc[ai][bj][m][1];
                    if (ACT == 2) {
#pragma unroll
                        for (int e = 0; e < 4; ++e) { const float a = fmaxf(v0[e], 0.f), b = fmaxf(v1[e], 0.f); v0[e] = a * a; v1[e] = b * b; } }
                    v0 = v0 * sc; v1 = v1 * sc; u32x4 w; w.x = cvt_pk_bf16(v0[0], v0[1]); w.y = cvt_pk_bf16(v0[2], v0[3]); w.z = cvt_pk_bf16(v1[0], v1[1]); w.w = cvt_pk_bf16(v1[2], v1[3]);
                    *(u32x4*)(rowp + bj * HALF) = w; } }
    }
};
struct EpiF32 {
    static constexpr bool PERM = false, AFTER_DRAIN = false;
    float* O; int ldc;
    __device__ __forceinline__ void operator()(const f32x4 (&acc)[2][2][4][2], const Unit& u, int wr, int wc, int fr, int fq) const {
        const int col0 = u.pn * BM + wc * 32 + 4 * fq;
#pragma unroll
        for (int ai = 0; ai < 2; ++ai)
#pragma unroll
            for (int m = 0; m < 4; ++m) { const int r = ai * HALF + wr * 64 + m * 16 + fr; const size_t off = (size_t)(u.pm * BM + r) * ldc + col0;
#pragma unroll
                for (int bj = 0; bj < 2; ++bj)
#pragma unroll
                    for (int n = 0; n < 2; ++n) *(f32x4*)(O + off + bj * HALF + n * 16) = acc[ai][bj][m][n]; }
    }
};

template <class Epi, class Sched, bool ALIGN_EPI = false, bool SP2 = false>
__device__ __forceinline__ void gemm_phase(PG8_LAS unsigned char* lds, const Gemm g, const Sched& S, const Epi& E, int tid_in) {
    int tid_ = tid_in; asm volatile("" : "+v"(tid_));
    const int tid = tid_, wid = __builtin_amdgcn_readfirstlane(tid >> 6), lane = tid & 63, wr = wid >> 2, wc = wid & 3, fr = lane & 15, fq = lane >> 4;
    const int K = g.K, nt = K / BK;
    unsigned voffA[2], voffB[2];
#pragma unroll
    for (int i = 0; i < 2; ++i) { int R, C; stage_rc(tid * 16 + i * 8192, R, C); const int Rb = Epi::PERM ? ((R & ~31) + perm32(R & 31)) : R;
        voffA[i] = (unsigned)(R * K + C) * 2u; voffB[i] = (unsigned)(Rb * K + C) * 2u; }
    const size_t kstep = (size_t)(BK * 2);
    const size_t hstep = (size_t)HALF * K * 2;
    const size_t tstep = 2 * hstep;
    const unsigned ldsw = (unsigned)wid * 1024u;
    const int aoff = lds_byte(wr * 64 + fr, fq * 8), boff = lds_byte(wc * 32 + fr, fq * 8);
#define PG8_SA(b, h) (((b) * 2 + (h)) * HTB)
#define PG8_SB(b, h) ((4 + (b) * 2 + (h)) * HTB)
#define PG8_STAGE(bufoff, gbase, voff) do { _Pragma("unroll") for (int _i = 0; _i < 2; ++_i) \
        __builtin_amdgcn_global_load_lds((const unsigned*)((const char*)(gbase) + (voff)[_i]), (PG8_LAS unsigned*)(lds + (bufoff) + ldsw + _i * 8192), 16, 0, 0); } while (0)
#define PG8_LDA(dst, b, h) do { _Pragma("unroll") for (int m = 0; m < 4; ++m) _Pragma("unroll") for (int k = 0; k < 2; ++k) dst[m][k] = *(const PG8_LAS bf16x8*)(lds + PG8_SA(b, h) + aoff + m * 2048 + k * 1024); } while (0)
#define PG8_LDB(dst, b, h) do { _Pragma("unroll") for (int n = 0; n < 2; ++n) _Pragma("unroll") for (int k = 0; k < 2; ++k) dst[n][k] = *(const PG8_LAS bf16x8*)(lds + PG8_SB(b, h) + boff + n * 2048 + k * 1024); } while (0)
#define PG8_MMA(ai, bj, At, Bt) do { __builtin_amdgcn_s_setprio(1); _Pragma("unroll") for (int m = 0; m < 4; ++m) _Pragma("unroll") for (int n = 0; n < 2; ++n) _Pragma("unroll") for (int k = 0; k < 2; ++k) \
        acc[ai][bj][m][n] = __builtin_amdgcn_mfma_f32_16x16x32_bf16(Bt[n][k], At[m][k], acc[ai][bj][m][n], 0, 0, 0); __builtin_amdgcn_s_setprio(0); } while (0)
#define PG8_WAIT_V(n) asm volatile("s_waitcnt vmcnt(" #n ")" ::: "memory")
#define PG8_WAIT_L(n) asm volatile("s_waitcnt lgkmcnt(" #n ")" ::: "memory")
#define PG8_BAR __builtin_amdgcn_s_barrier()
#define PG8_SCHED __builtin_amdgcn_sched_barrier(0)
    Unit cur, nxt; int ui = 0;
    if (!S.next(0, cur)) return;
    f32x4 acc[2][2][4][2];
#pragma unroll
    for (int a = 0; a < 2; ++a)
#pragma unroll
        for (int b = 0; b < 2; ++b)
#pragma unroll
            for (int m = 0; m < 4; ++m)
#pragma unroll
                for (int n = 0; n < 2; ++n) acc[a][b][m][n] = (f32x4){0.f, 0.f, 0.f, 0.f};
    bf16x8 At[4][2], B0[2][2], B1[2][2];
    const char* cA = (const char*)g.A + (size_t)cur.pm * tstep; const char* cB = (const char*)g.Bt + (size_t)cur.pn * tstep;
    S.a_ready(cur);
    if constexpr (SP2) {
        PG8_STAGE(PG8_SB(0, 0), cB, voffB); PG8_STAGE(PG8_SB(0, 1), cB + hstep, voffB); PG8_STAGE(PG8_SA(0, 0), cA, voffA); PG8_STAGE(PG8_SA(0, 1), cA + hstep, voffA);
        if (wr == 1) PG8_BAR;
        PG8_WAIT_V(2); PG8_BAR;
        PG8_STAGE(PG8_SB(1, 0), cB + kstep, voffB); PG8_STAGE(PG8_SA(1, 0), cA + kstep, voffA); PG8_STAGE(PG8_SB(1, 1), cB + hstep + kstep, voffB);
        PG8_WAIT_V(6); PG8_BAR;
    } else {
        PG8_STAGE(PG8_SB(0, 0), cB, voffB); PG8_STAGE(PG8_SA(0, 0), cA, voffA); PG8_STAGE(PG8_SB(0, 1), cB + hstep, voffB); PG8_STAGE(PG8_SA(0, 1), cA + hstep, voffA);
        if (wr == 1) PG8_BAR;
        PG8_WAIT_V(4); PG8_BAR;
        PG8_STAGE(PG8_SB(1, 0), cB + kstep, voffB); PG8_STAGE(PG8_SA(1, 0), cA + kstep, voffA); PG8_STAGE(PG8_SB(1, 1), cB + hstep + kstep, voffB);
        PG8_WAIT_V(6); PG8_BAR;
    }
    for (;;) {
        const bool has_next = S.next(ui + 1, nxt);
        const char* nA = has_next ? (const char*)g.A + (size_t)nxt.pm * tstep : cA; const char* nB = has_next ? (const char*)g.Bt + (size_t)nxt.pn * tstep : cB;
        for (int t = 0; t < nt; t += 2) {
            const bool last = (t == nt - 2);
            const char* a1 = cA + (size_t)(t + 1) * kstep;
            const char* a2 = last ? nA : cA + (size_t)(t + 2) * kstep; const char* b2 = last ? nB : cB + (size_t)(t + 2) * kstep;
            const char* a3 = a2 + kstep; const char* b3 = b2 + kstep;
            if (last && has_next) S.a_ready(nxt);
            if constexpr (SP2) {
            PG8_LDB(B0, 0, 0); PG8_LDB(B1, 0, 1); PG8_SCHED; PG8_LDA(At, 0, 0); PG8_STAGE(PG8_SA(1, 1), a1 + hstep, voffA);
            PG8_WAIT_V(8); PG8_WAIT_L(0); PG8_BAR; PG8_MMA(0, 0, At, B0); PG8_MMA(0, 1, At, B1); PG8_BAR; PG8_SCHED;
            PG8_LDA(At, 0, 1); PG8_STAGE(PG8_SB(0, 0), b2, voffB); PG8_STAGE(PG8_SB(0, 1), b2 + hstep, voffB); PG8_STAGE(PG8_SA(0, 0), a2, voffA);
            PG8_WAIT_V(8); PG8_WAIT_L(0); PG8_BAR; PG8_MMA(1, 0, At, B0); PG8_MMA(1, 1, At, B1); PG8_BAR; PG8_SCHED;
            PG8_LDB(B0, 1, 0); PG8_LDB(B1, 1, 1); PG8_SCHED; PG8_LDA(At, 1, 0); PG8_STAGE(PG8_SA(0, 1), a2 + hstep, voffA);
            PG8_WAIT_V(8); PG8_WAIT_L(0); PG8_BAR; PG8_MMA(0, 0, At, B0); PG8_MMA(0, 1, At, B1); PG8_BAR; PG8_SCHED;
            PG8_LDA(At, 1, 1); PG8_STAGE(PG8_SB(1, 0), b3, voffB); PG8_STAGE(PG8_SB(1, 1), b3 + hstep, voffB); PG8_STAGE(PG8_SA(1, 0), a3, voffA);
            PG8_WAIT_V(8); PG8_WAIT_L(0); PG8_BAR; PG8_MMA(1, 0, At, B0); PG8_MMA(1, 1, At, B1); PG8_BAR; PG8_SCHED;
            } else {
            PG8_LDB(B0, 0, 0); PG8_SCHED; PG8_LDA(At, 0, 0); PG8_STAGE(PG8_SA(1, 1), a1 + hstep, voffA);
            PG8_WAIT_L(8); PG8_BAR; PG8_WAIT_L(0); PG8_MMA(0, 0, At, B0); PG8_BAR; PG8_SCHED;
            PG8_LDB(B1, 0, 1); PG8_STAGE(PG8_SB(0, 0), b2, voffB);
            PG8_BAR; PG8_WAIT_L(0); PG8_MMA(0, 1, At, B1); PG8_BAR;
            PG8_LDA(At, 0, 1); PG8_STAGE(PG8_SA(0, 0), a2, voffA);
            PG8_BAR; PG8_WAIT_L(0); PG8_MMA(1, 0, At, B0); PG8_BAR; PG8_SCHED;
            PG8_STAGE(PG8_SB(0, 1), b2 + hstep, voffB);
            PG8_WAIT_V(6); PG8_BAR; PG8_MMA(1, 1, At, B1); PG8_BAR;
            PG8_LDB(B0, 1, 0); PG8_SCHED; PG8_LDA(At, 1, 0); PG8_STAGE(PG8_SA(0, 1), a2 + hstep, voffA);
            PG8_WAIT_L(8); PG8_BAR; PG8_WAIT_L(0); PG8_MMA(0, 0, At, B0); PG8_BAR; PG8_SCHED;
            PG8_LDB(B1, 1, 1); PG8_STAGE(PG8_SB(1, 0), b3, voffB);
            PG8_BAR; PG8_WAIT_L(0); PG8_MMA(0, 1, At, B1); PG8_BAR;
            PG8_LDA(At, 1, 1); PG8_STAGE(PG8_SA(1, 0), a3, voffA);
            PG8_BAR; PG8_WAIT_L(0); PG8_MMA(1, 0, At, B0); PG8_BAR; PG8_SCHED;
            PG8_STAGE(PG8_SB(1, 1), b3 + hstep, voffB);
            PG8_WAIT_V(6); PG8_BAR; PG8_MMA(1, 1, At, B1); PG8_BAR;
            }
        }
        if constexpr (ALIGN_EPI) { if (wr == 0) PG8_BAR; }
        if constexpr (!Epi::AFTER_DRAIN) { E(acc, cur, wr, wc, fr, fq); S.done(cur); }
        if (!has_next) break;
#pragma unroll
        for (int a = 0; a < 2; ++a)
#pragma unroll
            for (int b = 0; b < 2; ++b)
#pragma unroll
                for (int m = 0; m < 4; ++m)
#pragma unroll
                    for (int n = 0; n < 2; ++n) acc[a][b][m][n] = (f32x4){0.f, 0.f, 0.f, 0.f};
        cur = nxt; cA = nA; cB = nB; ++ui;
        if constexpr (ALIGN_EPI) { if (wr == 1) PG8_BAR; }
    }
    PG8_WAIT_V(0);
    if constexpr (!ALIGN_EPI) { if (wr == 0) PG8_BAR; }
    PG8_BAR;
    if constexpr (Epi::AFTER_DRAIN) { E.fused(acc, cur, wr, wc, fr, fq, lds, wid, lane); S.done(cur); }
#undef PG8_SA
#undef PG8_SB
#undef PG8_STAGE
#undef PG8_LDA
#undef PG8_LDB
#undef PG8_MMA
#undef PG8_WAIT_V
#undef PG8_WAIT_L
#undef PG8_BAR
#undef PG8_SCHED
}
}
#define GAS __attribute__((address_space(1)))
#define LAS __attribute__((address_space(3)))
typedef unsigned short bf16;
typedef unsigned v4u __attribute__((ext_vector_type(4)));
typedef float f32x4 __attribute__((ext_vector_type(4)));
typedef short bf16x8 __attribute__((ext_vector_type(8)));
typedef GAS unsigned gu32;
typedef GAS unsigned long long gu64;
#define RLX_AGENT __ATOMIC_RELAXED, __HIP_MEMORY_SCOPE_AGENT
#define LDS_WAIT() asm volatile("s_waitcnt lgkmcnt(0)" ::: "memory")
#define VM_WAIT() asm volatile("s_waitcnt vmcnt(0)" ::: "memory")
__device__ __forceinline__ unsigned long long rt() { return __builtin_amdgcn_s_memrealtime(); }
__device__ __forceinline__ unsigned f2bf(float f) { unsigned u = __builtin_bit_cast(unsigned, f); return (u + 0x7fffu + ((u >> 16) & 1u)) >> 16; }
__device__ __forceinline__ unsigned pk2(float lo, float hi) { return f2bf(lo) | (f2bf(hi) << 16); }

#define XB_TMO      128
#define XB_XCNT(j)  (256  + 64 * (j))
#define XB_XSUB(j)  (1280 + 64 * (j))
#define XB_XGEN(j)  (2304 + 64 * (j))
#define XB_TOP      3328
#define XB_TOPGEN   3392
#define XCD_BAR_WORDS 3456
#define XB_SPIN_CAP (1u << 21)

__device__ __forceinline__ unsigned xb_ld(unsigned* p)              { return __hip_atomic_load(p, __ATOMIC_RELAXED, __HIP_MEMORY_SCOPE_AGENT); }
__device__ __forceinline__ unsigned xb_add(unsigned* p, unsigned v) { return __hip_atomic_fetch_add(p, v, __ATOMIC_RELAXED, __HIP_MEMORY_SCOPE_AGENT); }
__device__ __forceinline__ unsigned xb_xcc_id() { return (unsigned)__builtin_amdgcn_s_getreg((3 << 11) | 20) & 0xFu; }
#define XB_SPIN(cond, bar) do { unsigned _sp = 0; while (cond) { __builtin_amdgcn_s_sleep(1); \
    if ((++_sp & 255u) == 0u) { if (xb_ld(&(bar)[XB_TMO])) break; if (_sp > XB_SPIN_CAP) { atomicAdd(&(bar)[XB_TMO], 1u); break; } } } } while (0)

struct XcdBarrier {
    unsigned* bar; unsigned x;
    volatile LAS unsigned* st;
};

__device__ __forceinline__ XcdBarrier xcd_barrier_post(unsigned* bar, volatile LAS unsigned* st) {
    XcdBarrier b; b.bar = bar; b.x = xb_xcc_id(); b.st = st;
    if (threadIdx.x == 0) (void)xb_add(&bar[XB_XCNT(b.x)], 1u);
    return b;
}
__device__ __forceinline__ void xcd_barrier_complete(unsigned* bar, unsigned x, unsigned& nloc, unsigned& nx) {
    const unsigned G = gridDim.x * gridDim.y * gridDim.z;
    unsigned sum, cnt, mine, sp = 0u;
    for (;;) {
        sum = 0u; cnt = 0u; mine = 0u;
#pragma unroll
        for (unsigned j = 0; j < 16; ++j) { const unsigned c = xb_ld(&bar[XB_XCNT(j)]); sum += c; cnt += (c > 0u) ? 1u : 0u; mine = (j == x) ? c : mine; }
        if (sum == G) break;
        __builtin_amdgcn_s_sleep(1);
        if ((++sp & 255u) == 0u) { if (xb_ld(&bar[XB_TMO])) break; if (sp > XB_SPIN_CAP) { atomicAdd(&bar[XB_TMO], 1u); break; } }
    }
    nloc = mine > 0u ? mine : 1u; nx = cnt > 0u ? cnt : 1u;
}

__device__ __forceinline__ void xcd_barrier(const XcdBarrier& b, const bool is_t0  ) {
    asm volatile("s_waitcnt vmcnt(0)" ::: "memory");
    __syncthreads();
    if (is_t0) {
        unsigned* bar = b.bar;
        __builtin_amdgcn_s_waitcnt(0);
        unsigned nloc = b.st[0], nx = b.st[1];
        if (nloc == 0u) { xcd_barrier_complete(bar, b.x, nloc, nx); b.st[0] = nloc; b.st[1] = nx; }
        const unsigned old = xb_add(&bar[XB_XSUB(b.x)], 1u);
        const unsigned gen = old / nloc;
        if (old + 1u == (gen + 1u) * nloc) {
            __builtin_amdgcn_fence(__ATOMIC_RELEASE, "agent");
            asm volatile("s_waitcnt vmcnt(0)" ::: "memory");
            const unsigned og = xb_add(&bar[XB_TOP], 1u);
            const unsigned tg = og / nx;
            if (og + 1u == (tg + 1u) * nx) xb_add(&bar[XB_TOPGEN], 1u);
            else XB_SPIN(xb_ld(&bar[XB_TOPGEN]) == tg, bar);
            __builtin_amdgcn_fence(__ATOMIC_ACQUIRE, "agent");
            xb_add(&bar[XB_XGEN(b.x)], 1u);
            asm volatile("s_waitcnt vmcnt(0)" ::: "memory");
        } else {
            XB_SPIN(xb_ld(&bar[XB_XGEN(b.x)]) == gen, bar);
            __builtin_amdgcn_fence(__ATOMIC_ACQUIRE, "agent");
            asm volatile("s_waitcnt vmcnt(0)" ::: "memory");
        }
    }
    __syncthreads();
}

namespace moba {
using bf16x8 = __attribute__((ext_vector_type(8))) short;
using s16x4  = __attribute__((ext_vector_type(4))) short;
using f32x16 = __attribute__((ext_vector_type(16))) float;
using u32x4  = __attribute__((ext_vector_type(4))) unsigned;
typedef unsigned short bf16;
constexpr int KVBLK = 64, LDK = 1024, NT = 4;
constexpr int SHM_V = KVBLK * 128 * 2, SHM_K = SHM_V;
constexpr int OFF_WS = 2 * SHM_V + 2 * SHM_K, OFF_RO = OFF_WS + 8 * 64 * 4, LDS_ATTN = OFF_RO + 8 * 32 * 4;
constexpr float THR2 = 11.5f;
#define KSWZ(row, colB) ((row) * 256 + ((colB) ^ (((row) & 7) << 4)))
#define SBAR() __builtin_amdgcn_sched_barrier(0)
__device__ __forceinline__ int crow(int r, int hi) { return (r & 3) + 8 * (r >> 2) + 4 * hi; }
__device__ __forceinline__ unsigned cvtpk(float lo, float hi) { unsigned r; asm volatile("v_cvt_pk_bf16_f32 %0, %1, %2" : "=v"(r) : "v"(lo), "v"(hi)); return r; }

__device__ __forceinline__ void partialSM(f32x16& p0, f32x16& p1, float& m_reg, float& mn, float& alpha) {
  float pmax = p0[0];
#pragma unroll
  for (int r = 1; r < 16; ++r) pmax = fmaxf(pmax, p0[r]);
#pragma unroll
  for (int r = 0; r < 16; ++r) pmax = fmaxf(pmax, p1[r]);
  { auto rr = __builtin_amdgcn_permlane32_swap(__float_as_uint(pmax), __float_as_uint(pmax), false, false);
    pmax = fmaxf(__uint_as_float(rr[0]), __uint_as_float(rr[1])); }
  if (__builtin_expect(__all(pmax - m_reg <= THR2), 1)) { mn = m_reg; alpha = 1.f; }
  else { mn = fmaxf(m_reg, pmax); alpha = __builtin_amdgcn_exp2f(m_reg - mn); m_reg = mn; }
#pragma unroll
  for (int r = 0; r < 16; ++r) { p0[r] = p0[r] - mn; p1[r] = p1[r] - mn; }
#pragma unroll
  for (int r = 0; r < 16; ++r) p0[r] = __builtin_amdgcn_exp2f(p0[r]);
}
__device__ __forceinline__ void finishSM(f32x16& p0, f32x16& p1, float alpha, float& l_reg, bf16x8& pa0, bf16x8& pa1, bf16x8& pa2, bf16x8& pa3) {
#pragma unroll
  for (int r = 0; r < 16; ++r) p1[r] = __builtin_amdgcn_exp2f(p1[r]);
  float ps = 0;
#pragma unroll
  for (int r = 0; r < 16; ++r) ps += p0[r];
#pragma unroll
  for (int r = 0; r < 16; ++r) ps += p1[r];
  { auto rr = __builtin_amdgcn_permlane32_swap(__float_as_uint(ps), __float_as_uint(ps), false, false);
    ps = __uint_as_float(rr[0]) + __uint_as_float(rr[1]); }
  l_reg = l_reg * alpha + ps;
#define PK4(P, BASE, OUT) do { unsigned a0 = cvtpk(P[BASE + 0], P[BASE + 1]), a1 = cvtpk(P[BASE + 2], P[BASE + 3]);   \
    unsigned b0 = cvtpk(P[BASE + 4], P[BASE + 5]), b1 = cvtpk(P[BASE + 6], P[BASE + 7]);                              \
    auto r0 = __builtin_amdgcn_permlane32_swap(a0, b0, false, false); auto r1 = __builtin_amdgcn_permlane32_swap(a1, b1, false, false); \
    u32x4 w = {r0[0], r1[0], r0[1], r1[1]}; OUT = *reinterpret_cast<bf16x8*>(&w); } while (0)
  PK4(p0, 0, pa0); PK4(p0, 8, pa1); PK4(p1, 0, pa2); PK4(p1, 8, pa3);
#undef PK4
}
__device__ __forceinline__ void qkt(f32x16& p0, f32x16& p1, const char* Ks, const bf16x8* qr, int r32, int hi) {
  p0 = f32x16{}; p1 = f32x16{};
#pragma unroll
  for (int d0 = 0; d0 < 8; ++d0) { int cb = (d0 * 16 + hi * 8) * 2;
    bf16x8 b0 = *reinterpret_cast<const bf16x8*>(Ks + KSWZ(r32, cb));
    bf16x8 b1 = *reinterpret_cast<const bf16x8*>(Ks + KSWZ(32 + r32, cb));
    p0 = __builtin_amdgcn_mfma_f32_32x32x16_bf16(b0, qr[d0], p0, 0, 0, 0);
    p1 = __builtin_amdgcn_mfma_f32_32x32x16_bf16(b1, qr[d0], p1, 0, 0, 0); }
}
__device__ __forceinline__ void bias_mask(f32x16& p0, f32x16& p1, float tb, float sl2, int lim) {
#pragma unroll
  for (int r = 0; r < 16; ++r) { const int c = (r & 3) + 8 * (r >> 2);
    p0[r] += fmaf(sl2, (float)c, tb); p1[r] += fmaf(sl2, (float)(c + 32), tb);
    if (c > lim) p0[r] = -INFINITY; if (c + 32 > lim) p1[r] = -INFINITY; }
}
__device__ __forceinline__ int v_st(int k, int c) { const int kk = (k & ~0xC) | ((k & 4) << 1) | ((k & 8) >> 1); return ((kk >> 3) * 4 + (c >> 5)) * 512 + ((kk & 7) * 32 + (c & 31)) * 2; }
__device__ __forceinline__ int v_rd_base(int lane) { return ((lane & 3) << 3) | (((lane >> 2) & 3) << 6) | (((lane >> 4) & 1) << 5) | (((lane >> 5) & 1) << 8); }
constexpr int v_rd_off(int d0, int ks, int half) { return d0 * 512 + ks * 4096 + half * 2048; }
template <int OFF> __device__ __forceinline__ s16x4 tr_read(int vb) {
  s16x4 r; asm volatile("ds_read_b64_tr_b16 %0, %1 offset:%2" : "=&v"(r) : "v"(vb), "i"(OFF) : "memory"); return r;
}
template <int D0> __device__ __forceinline__ void pv_one(f32x16& od, int vb, bf16x8 pa0, bf16x8 pa1, bf16x8 pa2, bf16x8 pa3) {
  const s16x4 l0 = tr_read<v_rd_off(D0, 0, 0)>(vb), h0 = tr_read<v_rd_off(D0, 0, 1)>(vb), l1 = tr_read<v_rd_off(D0, 1, 0)>(vb), h1 = tr_read<v_rd_off(D0, 1, 1)>(vb);
  const s16x4 l2 = tr_read<v_rd_off(D0, 2, 0)>(vb), h2 = tr_read<v_rd_off(D0, 2, 1)>(vb), l3 = tr_read<v_rd_off(D0, 3, 0)>(vb), h3 = tr_read<v_rd_off(D0, 3, 1)>(vb);
  asm volatile("s_waitcnt lgkmcnt(0)" ::: "memory"); SBAR();
#define PK(L, H) (bf16x8){L[0], L[1], L[2], L[3], H[0], H[1], H[2], H[3]}
  od = __builtin_amdgcn_mfma_f32_32x32x16_bf16(pa0, PK(l0, h0), od, 0, 0, 0);
  od = __builtin_amdgcn_mfma_f32_32x32x16_bf16(pa1, PK(l1, h1), od, 0, 0, 0);
  od = __builtin_amdgcn_mfma_f32_32x32x16_bf16(pa2, PK(l2, h2), od, 0, 0, 0);
  od = __builtin_amdgcn_mfma_f32_32x32x16_bf16(pa3, PK(l3, h3), od, 0, 0, 0);
#undef PK
}
__device__ __forceinline__ void pv_d0(f32x16* o, int vb, bf16x8 pa0, bf16x8 pa1, bf16x8 pa2, bf16x8 pa3) {
  pv_one<0>(o[0], vb, pa0, pa1, pa2, pa3); pv_one<1>(o[1], vb, pa0, pa1, pa2, pa3); pv_one<2>(o[2], vb, pa0, pa1, pa2, pa3); pv_one<3>(o[3], vb, pa0, pa1, pa2, pa3);
}

__device__ __forceinline__ void attn_unit(const bf16* Qw, const bf16* Kh, const bf16* Vh, float lsecorr, int qlim, float sl2, bool valid, unsigned outoff, bf16* obase, float* lse, char* lds, int tid) {
  const int wid = tid >> 6, lane = tid & 63, r32 = lane & 31, hi = lane >> 5;
  char* V_lds = lds; char* K_lds = lds + 2 * SHM_V;
  float* wsf = (float*)(lds + OFF_WS) + wid * 64; float* li_l = wsf; float* al_l = wsf + 32; unsigned* ro_l = (unsigned*)(lds + OFF_RO) + wid * 32;
  float m_reg = -1e30f, l_reg = 0; f32x16 o[4] = {}; bf16x8 qr[8];
#pragma unroll
  for (int d0 = 0; d0 < 8; ++d0) qr[d0] = *reinterpret_cast<const bf16x8*>(Qw + d0 * 16);
  const int sr = tid >> 4, sc = (tid & 15) * 8, vst0 = v_st(sr, sc), vst1 = v_st(32 + sr, sc);
  const int vb0 = (int)(uintptr_t)V_lds + v_rd_base(lane);
  bf16x8 vs0, vs1, ks0, ks1;
#define SLOAD(k0) do { vs0 = *reinterpret_cast<const bf16x8*>(&Vh[(long)((k0) + sr) * LDK + sc]); vs1 = *reinterpret_cast<const bf16x8*>(&Vh[(long)((k0) + 32 + sr) * LDK + sc]); \
    ks0 = *reinterpret_cast<const bf16x8*>(&Kh[(long)((k0) + sr) * LDK + sc]); ks1 = *reinterpret_cast<const bf16x8*>(&Kh[(long)((k0) + 32 + sr) * LDK + sc]); } while (0)
#define SWRITE(b) do { *(bf16x8*)(V_lds + (b) * SHM_V + vst0) = vs0; *(bf16x8*)(V_lds + (b) * SHM_V + vst1) = vs1; const int kc = sc * 2; \
    *(bf16x8*)(K_lds + (b) * SHM_K + KSWZ(sr, kc)) = ks0; *(bf16x8*)(K_lds + (b) * SHM_K + KSWZ(32 + sr, kc)) = ks1; } while (0)
  const float tb0 = sl2 * (float)(4 * hi), tstep = sl2 * 64.f; const int lim0 = qlim - 4 * hi;
  SLOAD(0); SWRITE(0); __syncthreads();
#pragma unroll
  for (int t = 0; t < NT; ++t) {
    if (t + 1 < NT) SLOAD((t + 1) * KVBLK);
    f32x16 p0, p1; float mn, alpha; bf16x8 pa0, pa1, pa2, pa3;
    qkt(p0, p1, K_lds + (t & 1) * SHM_K, qr, r32, hi);
    bias_mask(p0, p1, tb0 + tstep * (float)t, sl2, lim0 - 64 * t);
    partialSM(p0, p1, m_reg, mn, alpha);
    finishSM(p0, p1, alpha, l_reg, pa0, pa1, pa2, pa3);
    if (__any(alpha < 1.f)) { if (hi == 0) al_l[r32] = alpha; asm volatile("s_waitcnt lgkmcnt(0)" ::: "memory");
#pragma unroll
      for (int d = 0; d < 4; ++d)
#pragma unroll
        for (int r = 0; r < 16; ++r) o[d][r] *= al_l[crow(r, hi)]; }
    SBAR();
    pv_d0(o, vb0 + (t & 1) * SHM_V, pa0, pa1, pa2, pa3);
    if (t + 1 < NT) { SWRITE((t + 1) & 1); __syncthreads(); }
  }
  if (hi == 0) { li_l[r32] = l_reg; ro_l[r32] = valid ? outoff : 0xffffffffu; if (valid) *lse = m_reg + __builtin_amdgcn_logf(l_reg) + lsecorr; }
  asm volatile("s_waitcnt lgkmcnt(0)" ::: "memory");
#pragma unroll
  for (int r = 0; r < 16; ++r) { const int orow = crow(r, hi); const float rl = __builtin_amdgcn_rcpf(li_l[orow]); const unsigned off = ro_l[orow];
    if (off != 0xffffffffu) {
#pragma unroll
      for (int d0 = 0; d0 < 4; ++d0) obase[(size_t)off + d0 * 32 + r32] = (bf16)(cvtpk(o[d0][r] * rl, 0.f) & 0xffffu); } }
  __syncthreads();
#undef SLOAD
#undef SWRITE
}
#undef KSWZ
#undef SBAR
}

constexpr int NWAVES = 8, NTHR = NWAVES * 64;
constexpr int BATCH = 2, T = 8192, D = 1024, M = BATCH * T, FF = 4096;
constexpr int NH = 8, DH = 128, BLK = 256, NBLK = T / BLK;
constexpr int LH = 8, DQK = 64, DV = 128, LC = 64, NCH = T / LC;
constexpr int NIN = 2 * LH * DQK + 2 * LH * DV + 2 * LH;
constexpr int NIN_G = 3072;
constexpr float RMS_EPS = 1e-6f, SOFTCAP = 15.0f;
constexpr float LOG2E = 1.4426950408889634f;
constexpr float QSCALE = 0.08838834764831845f * LOG2E;
constexpr float NEG_BIG = -1e30f;

constexpr size_t MiB = 1u << 20;
constexpr size_t WS_CTL = 0, CTL_ZERO_BYTES = 1 * MiB;
constexpr size_t WS_USUM = 1 * MiB;
constexpr size_t WS_KMEAN = 2 * MiB;
constexpr size_t WS_G = 3 * MiB;
constexpr size_t WS_XNLO = 160 * MiB;
constexpr size_t WS_MASK = 5 * MiB;
constexpr size_t WS_LIST = 1 * MiB;
constexpr size_t WS_CNT = 5 * MiB + 512 * 1024;
constexpr size_t WS_LSE = 6 * MiB;
constexpr size_t WS_PSEL = 160 * MiB;
constexpr size_t WS_GIF = 6 * MiB;
constexpr size_t WS_SMALL = 7 * MiB;
constexpr size_t WS_W = 8 * MiB;
constexpr size_t WS_XN = 32 * MiB;
constexpr size_t WS_QKV = 64 * MiB;
constexpr size_t WS_DC = 160 * MiB;
constexpr size_t WS_U = 192 * MiB;
constexpr size_t WS_END = 256 * MiB;
constexpr int CW_BAR = 4096;

constexpr int RING_BYTES = 131072;
constexpr int LDS_BYTES = 147456;
constexpr int LDSCTL_OFF = LDS_BYTES - 512, MISC_OFF = LDSCTL_OFF + 320;

__device__ __forceinline__ float bperm_f(int srclane, float v) { return __int_as_float(__builtin_amdgcn_ds_bpermute(srclane << 2, __float_as_int(v))); }
__device__ __forceinline__ int bperm_i(int srclane, int v) { return __builtin_amdgcn_ds_bpermute(srclane << 2, v); }
__device__ __forceinline__ float rdlane_f(float v, int l) { return __int_as_float(__builtin_amdgcn_readlane(__float_as_int(v), l)); }
__device__ __forceinline__ float wave_sum(float v, int lane) {
#pragma unroll
    for (int o = 1; o < 64; o <<= 1) v += bperm_f(lane ^ o, v);
    return v;
}
__device__ __forceinline__ float wave_max(float v, int lane) {
#pragma unroll
    for (int o = 1; o < 64; o <<= 1) v = fmaxf(v, bperm_f(lane ^ o, v));
    return v;
}
__device__ __forceinline__ float bf_lo(unsigned w) { return __uint_as_float(w << 16); }
__device__ __forceinline__ float bf_hi(unsigned w) { return __uint_as_float(w & 0xffff0000u); }
__device__ __forceinline__ float bf1(bf16 h) { return __uint_as_float(((unsigned)h) << 16); }

__device__ __forceinline__ void transpose_item(const float* W, int K, int N, int ld, bf16* WT, LAS float* scr, int item, int lane) {
    const int nblk = N / 32, kb = item / nblk, nb = item % nblk, k0 = 64 * kb, n0 = 32 * nb;
#pragma unroll 8
    for (int i = 0; i < 32; ++i) { const int kk = 2 * i + (lane >> 5); scr[kk * 33 + (lane & 31)] = W[(size_t)(k0 + kk) * ld + n0 + (lane & 31)]; }
    LDS_WAIT(); asm volatile("" ::: "memory");
    const int c = lane & 7;
#pragma unroll
    for (int j = 0; j < 4; ++j) { const int n = (lane >> 3) + 8 * j; const LAS float* s = scr + (8 * c) * 33 + n;
        v4u o; o.x = pk2(s[0 * 33], s[1 * 33]); o.y = pk2(s[2 * 33], s[3 * 33]); o.z = pk2(s[4 * 33], s[5 * 33]); o.w = pk2(s[6 * 33], s[7 * 33]);
        *(GAS v4u*)(WT + (size_t)(n0 + n) * K + k0 + 8 * c) = o; }
    LDS_WAIT(); asm volatile("" ::: "memory");
}
__device__ __forceinline__ void convert_weights(const float* wmix_in, int ld_in, const float* wmix_out, const float* wup, const float* wdown, unsigned char* ws, LAS unsigned char* lds, int gw, int NGW, int wave, int lane) {
    LAS float* scr = (LAS float*)(lds + wave * 16384);
    bf16* W_IN = (bf16*)(ws + WS_W); bf16* W_OUT = (bf16*)(ws + WS_W + 6 * MiB); bf16* W_UP = (bf16*)(ws + WS_W + 8 * MiB); bf16* W_DN = (bf16*)(ws + WS_W + 16 * MiB);
    constexpr int I_IN = (D / 64) * (3072 / 32), I_O = (D / 64) * (D / 32), I_UP = (D / 64) * (FF / 32), I_DN = (FF / 64) * (D / 32);
    for (int it = gw; it < I_IN + I_O + I_UP + I_DN; it += NGW) {
        int r = it;
        if (r < I_IN) { transpose_item(wmix_in, D, 3072, ld_in, W_IN, scr, r, lane); continue; } r -= I_IN;
        if (r < I_O) { transpose_item(wmix_out, D, D, D, W_OUT, scr, r, lane); continue; } r -= I_O;
        if (r < I_UP) { transpose_item(wup, D, FF, FF, W_UP, scr, r, lane); continue; } r -= I_UP;
        transpose_item(wdown, FF, D, D, W_DN, scr, r, lane);
    }
}

__device__ __forceinline__ void rms_row(const float* xrow, const float* gain, int lane, f32x4 (&u)[4]) {
    const GAS f32x4* xr = (const GAS f32x4*)xrow + lane; const GAS f32x4* gr = (const GAS f32x4*)gain + lane;
    float s = 0.f;
#pragma unroll
    for (int j = 0; j < 4; ++j) { u[j] = xr[64 * j]; s += (u[j].x * u[j].x + u[j].y * u[j].y) + (u[j].z * u[j].z + u[j].w * u[j].w); }
    const float r = 1.0f / sqrtf(wave_sum(s, lane) * (1.f / D) + RMS_EPS);
#pragma unroll
    for (int j = 0; j < 4; ++j) { const f32x4 g = gr[64 * j]; u[j] = u[j] * r * g; }
}
__device__ __forceinline__ void store_row_bf16(bf16* orow, int lane, const f32x4 (&u)[4]) {
    GAS unsigned long long* o8 = (GAS unsigned long long*)orow + lane;
#pragma unroll
    for (int j = 0; j < 4; ++j) o8[64 * j] = (unsigned long long)pk2(u[j].x, u[j].y) | ((unsigned long long)pk2(u[j].z, u[j].w) << 32);
}

__device__ __forceinline__ unsigned bf_rne(float f) { return f2bf(f); }
__device__ __forceinline__ void store_row_hilo(bf16* hrow, bf16* lrow, int lane, const f32x4 (&u)[4]) {
    GAS unsigned long long* h8 = (GAS unsigned long long*)hrow + lane; GAS unsigned long long* l8 = (GAS unsigned long long*)lrow + lane;
#pragma unroll
    for (int j = 0; j < 4; ++j) {
        const unsigned hx = f2bf(u[j].x), hy = f2bf(u[j].y), hz = f2bf(u[j].z), hw = f2bf(u[j].w);
        const unsigned lx = f2bf(u[j].x - __uint_as_float(hx << 16)), ly = f2bf(u[j].y - __uint_as_float(hy << 16)), lz = f2bf(u[j].z - __uint_as_float(hz << 16)), lw = f2bf(u[j].w - __uint_as_float(hw << 16));
        h8[64 * j] = (unsigned long long)(hx | (hy << 16)) | ((unsigned long long)(hz | (hw << 16)) << 32);
        l8[64 * j] = (unsigned long long)(lx | (ly << 16)) | ((unsigned long long)(lz | (lw << 16)) << 32);
    }
}
__device__ __forceinline__ void phase_p0(const float* x, const float* gain, unsigned char* ws, LAS unsigned char* lds, int wg, int G, int tid, int wave, int lane) {
    bf16* XN = (bf16*)(ws + WS_XN); bf16* XNLO = (bf16*)(ws + WS_XNLO); float* USUM = (float*)(ws + WS_USUM);
    LAS f32x4* red = (LAS f32x4*)lds;
    for (int part = wg; part < M / 64; part += G) {
        f32x4 acc[4];
#pragma unroll
        for (int j = 0; j < 4; ++j) acc[j] = (f32x4){0.f, 0.f, 0.f, 0.f};
        for (int i = 0; i < 8; ++i) {
            const int row = part * 64 + wave * 8 + i; f32x4 u[4];
            rms_row(x + (size_t)row * D, gain, lane, u);
            store_row_hilo(XN + (size_t)row * D, XNLO + (size_t)row * D, lane, u);
#pragma unroll
            for (int j = 0; j < 4; ++j) acc[j] = acc[j] + u[j];
        }
#pragma unroll
        for (int j = 0; j < 4; ++j) red[wave * 256 + 64 * j + lane] = acc[j];
        __syncthreads();
        if (tid < 256) { f32x4 s = red[tid];
#pragma unroll
            for (int w = 1; w < 8; ++w) s = s + red[w * 256 + tid];
            *((GAS f32x4*)(USUM + (size_t)part * 1024) + tid) = s; }
        __syncthreads();
    }
}
__device__ __forceinline__ void phase_kmean(const float* wqkv, unsigned char* ws, int wg, int G, int wave, int lane) {
    const float* USUM = (const float*)(ws + WS_USUM); float* KMEAN = (float*)(ws + WS_KMEAN);
    for (int cg = wg; cg < 256; cg += G) {
        f32x4 w[16];
#pragma unroll
        for (int kk = 0; kk < 16; ++kk) w[kk] = *(const GAS f32x4*)(wqkv + (size_t)(64 * kk + lane) * 3072 + 1024 + 4 * cg);
        for (int bl = 0; bl < 8; ++bl) {
            const int blk = wave * 8 + bl; f32x4 a = (f32x4){0.f, 0.f, 0.f, 0.f};
#pragma unroll
            for (int kk = 0; kk < 16; ++kk) { const int k = 64 * kk + lane; const float* up = USUM + (size_t)(4 * blk) * 1024 + k;
                const float us = (up[0] + up[1024]) + (up[2048] + up[3072]); a = a + w[kk] * us; }
            a.x = wave_sum(a.x, lane); a.y = wave_sum(a.y, lane); a.z = wave_sum(a.z, lane); a.w = wave_sum(a.w, lane);
            if (lane == 0) *(GAS f32x4*)(KMEAN + (size_t)blk * 1024 + 4 * cg) = a * (1.0f / 256.0f);
        }
    }
}
__device__ __forceinline__ void phase_g(const float* wqkv, unsigned char* ws, int wg, int G, int wave, int lane) {
    const float* KMEAN = (const float*)(ws + WS_KMEAN); bf16* GH = (bf16*)(ws + WS_G); bf16* GL = GH + 512 * 1024;
    for (int unit = wg; unit < 256; unit += G) {
        const int h = unit & 7, kg = (unit >> 3) & 15, bh = unit >> 7, k = 64 * kg + lane;
        const float* wq = wqkv + (size_t)k * 3072 + h * 128;
        float acc[4] = {0.f, 0.f, 0.f, 0.f};
        for (int dc = 0; dc < 128; dc += 32) {
            f32x4 wv[8];
#pragma unroll
            for (int i = 0; i < 8; ++i) wv[i] = *(const GAS f32x4*)(wq + dc + 4 * i);
#pragma unroll
            for (int bl = 0; bl < 4; ++bl) { const int blk = bh * 32 + wave * 4 + bl; const float* km = KMEAN + (size_t)blk * 1024 + h * 128 + dc;
#pragma unroll
                for (int i = 0; i < 8; ++i) { const f32x4 kv = *(const GAS f32x4*)(km + 4 * i); acc[bl] += (wv[i].x * kv.x + wv[i].y * kv.y) + (wv[i].z * kv.z + wv[i].w * kv.w); } }
        }
#pragma unroll
        for (int bl = 0; bl < 4; ++bl) { const int blk = bh * 32 + wave * 4 + bl, b = blk >> 5, n = blk & 31; const size_t gi = ((size_t)(b * 256 + h * 32 + n)) * 1024 + k;
            const unsigned gh = f2bf(acc[bl]); GH[gi] = (bf16)gh; GL[gi] = (bf16)f2bf(acc[bl] - __uint_as_float(gh << 16)); }
    }
}
__device__ __forceinline__ void phase_gate(unsigned char* ws, LAS unsigned char* lds, int wg, int G, int wave, int lane) {
    typedef short b8 __attribute__((ext_vector_type(8))); typedef float f16v __attribute__((ext_vector_type(16)));
    const bf16* XH = (const bf16*)(ws + WS_XN); const bf16* XL = (const bf16*)(ws + WS_XNLO); const bf16* GH = (const bf16*)(ws + WS_G); const bf16* GL = GH + 512 * 1024;
    unsigned* MASKT = (unsigned*)(ws + WS_MASK);
    LAS float* gl = (LAS float*)(lds + wave * 8448);
    const int r32 = lane & 31, hi = lane >> 5, h = wave;
    for (int tile = wg; tile < M / 64; tile += G) {
        const int row0 = tile * 64, b = row0 >> 13, s0 = row0 & (T - 1), npast = s0 >> 8;
        if (npast == 0) { MASKT[((size_t)(b * 8 + h)) * T + s0 + lane] = 0u; continue; }
        f16v acc0, acc1;
#pragma unroll
        for (int i = 0; i < 16; ++i) { acc0[i] = 0.f; acc1[i] = 0.f; }
        const bf16* a0h = XH + (size_t)(row0 + r32) * D + 8 * hi; const bf16* a0l = XL + (size_t)(row0 + r32) * D + 8 * hi;
        const bf16* gbh = GH + ((size_t)(b * 256 + h * 32 + r32)) * D + 8 * hi; const bf16* gbl = GL + ((size_t)(b * 256 + h * 32 + r32)) * D + 8 * hi;
#pragma unroll 4
        for (int ks = 0; ks < D / 16; ++ks) {
            const int k = 16 * ks;
            const b8 A0h = *(const GAS b8*)(a0h + k), A0l = *(const GAS b8*)(a0l + k), A1h = *(const GAS b8*)(a0h + 32 * D + k), A1l = *(const GAS b8*)(a0l + 32 * D + k);
            const b8 Bh = *(const GAS b8*)(gbh + k), Bl = *(const GAS b8*)(gbl + k);
            acc0 = __builtin_amdgcn_mfma_f32_32x32x16_bf16(A0h, Bh, acc0, 0, 0, 0); acc1 = __builtin_amdgcn_mfma_f32_32x32x16_bf16(A1h, Bh, acc1, 0, 0, 0);
            acc0 = __builtin_amdgcn_mfma_f32_32x32x16_bf16(A0l, Bh, acc0, 0, 0, 0); acc1 = __builtin_amdgcn_mfma_f32_32x32x16_bf16(A1l, Bh, acc1, 0, 0, 0);
            acc0 = __builtin_amdgcn_mfma_f32_32x32x16_bf16(A0h, Bl, acc0, 0, 0, 0); acc1 = __builtin_amdgcn_mfma_f32_32x32x16_bf16(A1h, Bl, acc1, 0, 0, 0);
        }
#pragma unroll
        for (int i = 0; i < 16; ++i) { const int r = (i & 3) + 8 * (i >> 2) + 4 * hi; gl[r * 33 + r32] = acc0[i]; gl[(32 + r) * 33 + r32] = acc1[i]; }
        LDS_WAIT(); asm volatile("" ::: "memory");
        float v0 = -INFINITY, v1 = -INFINITY, v2 = -INFINITY; int i0 = 0, i1 = 0, i2 = 0;
        for (int n = 0; n < npast; ++n) {
            const float a = gl[lane * 33 + n];
            const bool c0 = a > v0, c1 = a > v1, c2 = a > v2;
            v2 = c1 ? v1 : (c2 ? a : v2); i2 = c1 ? i1 : (c2 ? n : i2);
            v1 = c0 ? v0 : (c1 ? a : v1); i1 = c0 ? i0 : (c1 ? n : i1);
            v0 = c0 ? a : v0; i0 = c0 ? n : i0;
        }
        unsigned mk = 1u << i0; if (npast > 1) mk |= 1u << i1; if (npast > 2) mk |= 1u << i2;
        MASKT[((size_t)(b * 8 + h)) * T + s0 + lane] = mk;
        LDS_WAIT(); asm volatile("" ::: "memory");
    }
}
__device__ __forceinline__ int list_base(int bh, int j) { return bh * 126976 + 256 * (31 * j - (j * (j - 1)) / 2); }
__device__ __forceinline__ void phase_lists(unsigned char* ws, int gw, int NGW, int lane) {
    const unsigned* MASKT = (const unsigned*)(ws + WS_MASK); unsigned short* LIST = (unsigned short*)(ws + WS_LIST); int* CNT = (int*)(ws + WS_CNT);
    for (int li = gw; li < 16 * 31; li += NGW) {
        const int bh = li / 31, j = li - bh * 31;
        const unsigned* mk = MASKT + (size_t)bh * T; unsigned short* dst = LIST + list_base(bh, j); int base = 0;
        for (int s0 = (j + 1) * BLK; s0 < T; s0 += 256) {
            const v4u m4 = *(const GAS v4u*)(mk + s0 + 4 * lane);
            const int f0 = (m4.x >> j) & 1, f1 = (m4.y >> j) & 1, f2 = (m4.z >> j) & 1, f3 = (m4.w >> j) & 1, c = f0 + f1 + f2 + f3;
            int inc = c;
#pragma unroll
            for (int o = 1; o < 64; o <<= 1) { const int t = bperm_i(lane - o, inc); if (lane >= o) inc += t; }
            int pos = base + inc - c; const int s = s0 + 4 * lane;
            if (f0) dst[pos++] = (unsigned short)s;
            if (f1) dst[pos++] = (unsigned short)(s + 1);
            if (f2) dst[pos++] = (unsigned short)(s + 2);
            if (f3) dst[pos++] = (unsigned short)(s + 3);
            base += __builtin_amdgcn_readlane(inc, 63);
        }
        if (lane == 0) CNT[li] = base;
    }
}
__device__ __forceinline__ void phase_attn(unsigned char* ws, char* lds, int wg, int G, int tid) {
    const bf16* Q = (const bf16*)(ws + WS_QKV); const bf16* K = Q + (size_t)M * D; const bf16* V = K + (size_t)M * D;
    const unsigned* MASKT = (const unsigned*)(ws + WS_MASK); const unsigned short* LIST = (const unsigned short*)(ws + WS_LIST); const int* CNT = (const int*)(ws + WS_CNT);
    bf16* POWN = (bf16*)(ws + WS_XN); bf16* PSEL = (bf16*)(ws + WS_PSEL); float* LSE = (float*)(ws + WS_LSE);
    int* pre = (int*)(lds + moba::LDS_ATTN);
    const int lane = tid & 63, wave = tid >> 6, r32 = lane & 31, hi = lane >> 5;
    {
        int c = (tid < 496) ? ((CNT[tid] + 255) >> 8) : 0;
#pragma unroll
        for (int o = 1; o < 64; o <<= 1) { const int t = bperm_i(lane - o, c); if (lane >= o) c += t; }
        int* wtot = pre + 512;
        if (lane == 63) wtot[wave] = c;
        __syncthreads();
        int add = 0;
#pragma unroll
        for (int w = 0; w < 8; ++w) if (w < wave) add += wtot[w];
        pre[tid] = c + add;
        __syncthreads();
    }
    const int total = __builtin_amdgcn_readfirstlane(512 + pre[495]);
    for (int u = wg; u < total; u += G) {
        int bh, jb, tile = 0, cnt = 256, own;
        if (u < 512) { bh = u >> 5; jb = u & 31; own = 1; }
        else {
            const int v = u - 512; int lo = 0, hi_ = 495;
            while (lo < hi_) { const int mid = (lo + hi_) >> 1; if (__builtin_amdgcn_readfirstlane(pre[mid]) > v) hi_ = mid; else lo = mid + 1; }
            const int li = lo; tile = v - (li ? __builtin_amdgcn_readfirstlane(pre[li - 1]) : 0); bh = li / 31; jb = li - bh * 31; own = 0;
            cnt = __builtin_amdgcn_readfirstlane(CNT[li]);
        }
        const int b = bh >> 3, h = bh & 7;
        const float sl2 = exp2f(-(float)(h + 1)) * LOG2E;
        const int idx = tile * 256 + wave * 32 + r32; const bool valid = idx < cnt;
        int sq, slot = 0;
        if (own) sq = jb * BLK + idx;
        else { sq = (int)LIST[list_base(bh, jb) + (valid ? idx : cnt - 1)]; slot = __builtin_popcount(MASKT[(size_t)bh * T + sq] & ((1u << jb) - 1u)); }
        const size_t m = (size_t)b * T + sq;
        const unsigned outoff = own ? (unsigned)(m * D + h * DH) : (unsigned)(((m * 8 + h) * 3 + slot) * DH);
        const size_t kv0 = ((size_t)b * T + jb * BLK) * D + h * DH;
        moba::attn_unit(Q + m * D + h * DH + hi * 8, K + kv0, V + kv0, -sl2 * (float)(sq - jb * BLK), own ? (wave * 32 + r32) : (1 << 20), sl2, valid, outoff, own ? POWN : PSEL,
                        LSE + (m * 8 + h) * 4 + (own ? 0 : 1 + slot), lds, tid);
    }
}
__device__ __forceinline__ void phase_combine(unsigned char* ws, int gtid, int NTH) {
    const unsigned* MASKT = (const unsigned*)(ws + WS_MASK); bf16* POWN = (bf16*)(ws + WS_XN); const bf16* PSEL = (const bf16*)(ws + WS_PSEL); const float* LSE = (const float*)(ws + WS_LSE);
    for (int e = gtid; e < M * NH * 16; e += NTH) {
        const int dg = e & 15, mh = e >> 4, h = mh & 7, m = mh >> 3, b = m >> 13, s = m & (T - 1);
        const int nsel = __builtin_popcount(MASKT[((size_t)(b * 8 + h)) * T + s]);
        const f32x4 l4 = *(const GAS f32x4*)(LSE + (size_t)mh * 4);
        float ls[4] = {l4.x, nsel > 0 ? l4.y : -INFINITY, nsel > 1 ? l4.z : -INFINITY, nsel > 2 ? l4.w : -INFINITY};
        const float mx = fmaxf(fmaxf(ls[0], ls[1]), fmaxf(ls[2], ls[3]));
        float w[4], den = 0.f;
#pragma unroll
        for (int p = 0; p < 4; ++p) { w[p] = exp2f(ls[p] - mx); den += w[p]; }
        const float inv = 1.0f / den;
        GAS v4u* own = (GAS v4u*)(POWN + (size_t)m * D + h * DH + dg * 8);
        float acc[8];
        { const v4u x = *own; const float ww = w[0] * inv;
          acc[0] = ww * bf_lo(x.x); acc[1] = ww * bf_hi(x.x); acc[2] = ww * bf_lo(x.y); acc[3] = ww * bf_hi(x.y); acc[4] = ww * bf_lo(x.z); acc[5] = ww * bf_hi(x.z); acc[6] = ww * bf_lo(x.w); acc[7] = ww * bf_hi(x.w); }
#pragma unroll
        for (int p = 1; p < 4; ++p) if (p <= nsel) { const v4u x = *(const GAS v4u*)(PSEL + ((size_t)mh * 3 + (p - 1)) * DH + dg * 8); const float ww = w[p] * inv;
          acc[0] += ww * bf_lo(x.x); acc[1] += ww * bf_hi(x.x); acc[2] += ww * bf_lo(x.y); acc[3] += ww * bf_hi(x.y); acc[4] += ww * bf_lo(x.z); acc[5] += ww * bf_hi(x.z); acc[6] += ww * bf_lo(x.w); acc[7] += ww * bf_hi(x.w); }
        v4u o; o.x = pk2(acc[0], acc[1]); o.y = pk2(acc[2], acc[3]); o.z = pk2(acc[4], acc[5]); o.w = pk2(acc[6], acc[7]);
        *own = o;
    }
}
template <bool SECOND, bool GATES>
__device__ __forceinline__ void norm_rows(const float* U, const float* hin, float* hout, const float* gpost, const float* gpre, bf16* XN, const LAS float* wg, const float* bg, float* GIF, int gw, int NGW, int lane) {
    for (int m = gw; m < M; m += NGW) {
        f32x4 u[4]; rms_row(U + (size_t)m * D, gpost, lane, u);
        const GAS f32x4* hr = (const GAS f32x4*)(hin + (size_t)m * D) + lane; GAS f32x4* ho = (GAS f32x4*)(hout + (size_t)m * D) + lane;
        float s = 0.f;
#pragma unroll
        for (int j = 0; j < 4; ++j) { u[j] = u[j] + hr[64 * j]; ho[64 * j] = u[j]; s += (u[j].x * u[j].x + u[j].y * u[j].y) + (u[j].z * u[j].z + u[j].w * u[j].w); }
        if (SECOND) {
            const float r = 1.0f / sqrtf(wave_sum(s, lane) * (1.f / D) + RMS_EPS); const GAS f32x4* gr = (const GAS f32x4*)gpre + lane;
#pragma unroll
            for (int j = 0; j < 4; ++j) u[j] = u[j] * r * gr[64 * j];
            store_row_bf16(XN + (size_t)m * D, lane, u);
            if (GATES) {
                float mine = 0.f;
#pragma unroll 1
                for (int g = 0; g < 16; ++g) { float a = 0.f;
#pragma unroll
                    for (int j = 0; j < 4; ++j) { const f32x4 w = *((const LAS f32x4*)(wg + g * 1024) + 64 * j + lane); a += (u[j].x * w.x + u[j].y * w.y) + (u[j].z * w.z + u[j].w * w.w); }
                    a = wave_sum(a, lane); if (lane == g) mine = a; }
                if (lane < 16) { const float z = SOFTCAP * tanhf((mine + bg[lane]) * (1.0f / SOFTCAP));
                    GIF[(size_t)m * 16 + lane] = (lane < 8) ? z : -log1pf(expf(-z)); }
            }
        }
    }
}
__device__ __forceinline__ float scan_add(float v, int lane) {
#pragma unroll
    for (int o = 1; o < 64; o <<= 1) { const float t = bperm_f(lane - o, v); if (lane >= o) v += t; }
    return v;
}
__device__ __forceinline__ float scan_max(float v, int lane) {
#pragma unroll
    for (int o = 1; o < 64; o <<= 1) { const float t = bperm_f(lane - o, v); if (lane >= o) v = fmaxf(v, t); }
    return v;
}
typedef short b8 __attribute__((ext_vector_type(8)));
typedef float f16v __attribute__((ext_vector_type(16)));
typedef __bf16 bf2_t __attribute__((ext_vector_type(2))); typedef float f2_t __attribute__((ext_vector_type(2)));
__device__ __forceinline__ unsigned pk_bf16(float a, float b) { f2_t v = {a, b}; bf2_t r = __builtin_convertvector(v, bf2_t); return __builtin_bit_cast(unsigned, r); }
__device__ __forceinline__ b8 mk_b8(unsigned a, unsigned b, unsigned c, unsigned d) { v4u w = {a, b, c, d}; return __builtin_bit_cast(b8, w); }
__device__ __forceinline__ b8 pack8(const float (&v)[8]) { return mk_b8(pk_bf16(v[0], v[1]), pk_bf16(v[2], v[3]), pk_bf16(v[4], v[5]), pk_bf16(v[6], v[7])); }
#define MFMA32(a, b, c) __builtin_amdgcn_mfma_f32_32x32x16_bf16((a), (b), (c), 0, 0, 0)
__device__ __forceinline__ void phase_mlstm_a(unsigned char* ws, LAS unsigned char* lds, int gw, int NGW, int wave, int lane) {
    const bf16* QK = (const bf16*)(ws + WS_QKV); const float* GIF = (const float*)(ws + WS_GIF);
    float* DC = (float*)(ws + WS_DC); float* BEND = (float*)(ws + WS_SMALL); float* MLOC = BEND + 2048; float* DN = BEND + 3 * 2048;
    float* BCUM = (float*)(ws + WS_USUM); float* GMX = BCUM + (size_t)M * 8;
    LAS float* wt = (LAS float*)(lds + wave * 16384);
    const int r32 = lane & 31, hh = lane >> 5;
    for (int unit = gw; unit < 16 * NCH; unit += NGW) {
        const int bh = unit >> 7, c = unit & 127, b = bh >> 3, h = bh & 7, tok0 = b * T + c * LC;
        const float lf = GIF[(size_t)(tok0 + lane) * 16 + 8 + h], li = GIF[(size_t)(tok0 + lane) * 16 + h];
        const float bc = scan_add(lf, lane), bend = rdlane_f(bc, 63), lw = bend - bc + li, mloc = wave_max(lw, lane), w = expf(lw - mloc);
        BCUM[(size_t)(tok0 + lane) * 8 + h] = bc; GMX[(size_t)(tok0 + lane) * 8 + h] = scan_max(li - bc, lane);
        wt[lane] = w;
        LDS_WAIT(); asm volatile("" ::: "memory");
        b8 Bf[2][4];
        const bf16* kcol = QK + (size_t)tok0 * NIN_G + 512 + h * DQK + r32;
#pragma unroll
        for (int dt = 0; dt < 2; ++dt)
#pragma unroll
            for (int ks = 0; ks < 4; ++ks) { float kv[8];
#pragma unroll
                for (int j = 0; j < 8; ++j) { const int s = 8 * hh + j + 16 * ks; kv[j] = bf1(kcol[(size_t)s * NIN_G + 32 * dt]) * wt[s]; }
                Bf[dt][ks] = pack8(kv); }
        const bf16* vcol = QK + (size_t)tok0 * NIN_G + 1024 + h * DV + r32;
#pragma unroll
        for (int vt = 0; vt < 5; ++vt) {
            f16v a0, a1;
#pragma unroll
            for (int i = 0; i < 16; ++i) { a0[i] = 0.f; a1[i] = 0.f; }
#pragma unroll
            for (int ks = 0; ks < 4; ++ks) { b8 Af;
                if (vt < 4) { unsigned e[8];
#pragma unroll
                    for (int j = 0; j < 8; ++j) { const int s = 8 * hh + j + 16 * ks; e[j] = (unsigned)vcol[(size_t)s * NIN_G + 32 * vt]; }
                    Af = mk_b8(e[0] | (e[1] << 16), e[2] | (e[3] << 16), e[4] | (e[5] << 16), e[6] | (e[7] << 16)); }
                else { const unsigned one = (r32 == 0) ? 0x3f803f80u : 0u; Af = mk_b8(one, one, one, one); }
                a0 = MFMA32(Af, Bf[0][ks], a0); a1 = MFMA32(Af, Bf[1][ks], a1); }
            if (vt < 4) {
#pragma unroll
                for (int i = 0; i < 16; ++i) { const int v = 32 * vt + (i & 3) + 8 * (i >> 2) + 4 * hh; float* dst = DC + ((size_t)unit * 128 + v) * 64 + r32; dst[0] = a0[i]; dst[32] = a1[i]; } }
            else if (hh == 0) { DN[(size_t)unit * 64 + r32] = a0[0]; DN[(size_t)unit * 64 + 32 + r32] = a1[0]; }
        }
        if (lane == 0) { BEND[unit] = bend; MLOC[unit] = mloc; }
        LDS_WAIT(); asm volatile("" ::: "memory");
    }
}
__device__ __forceinline__ void phase_mlstm_b(unsigned char* ws, int gtid, int NT) {
    float* DC = (float*)(ws + WS_DC); float* BEND = (float*)(ws + WS_SMALL); float* MLOC = BEND + 2048; float* MST = BEND + 2 * 2048; float* DN = BEND + 3 * 2048;
    for (int e = gtid; e < 16 * 8192 + 16 * 64; e += NT) {
        int bh; float* base; int stride; bool wm = false;
        if (e < 16 * 8192) { bh = e >> 13; base = DC + (size_t)bh * 128 * 8192 + (e & 8191); stride = 8192; }
        else { const int e2 = e - 16 * 8192; bh = e2 >> 6; base = DN + (size_t)bh * 128 * 64 + (e2 & 63); stride = 64; wm = (e2 & 63) == 0; }
        float mcur = 0.f, st = 0.f;
        for (int c0 = 0; c0 < NCH; c0 += 8) {
            float xv[8], be[8], ml[8];
#pragma unroll
            for (int i = 0; i < 8; ++i) { xv[i] = base[(size_t)(c0 + i) * stride]; be[i] = BEND[bh * 128 + c0 + i]; ml[i] = MLOC[bh * 128 + c0 + i]; }
#pragma unroll
            for (int i = 0; i < 8; ++i) {
                base[(size_t)(c0 + i) * stride] = st; if (wm) MST[bh * 128 + c0 + i] = mcur;
                const float mn = fmaxf(be[i] + mcur, ml[i]);
                st = expf(be[i] + mcur - mn) * st + expf(ml[i] - mn) * xv[i]; mcur = mn;
            }
        }
    }
}
constexpr int MLC_STRIDE = 17920;
__device__ __forceinline__ void phase_mlstm_c(const float* norm_h, unsigned char* ws, LAS unsigned char* lds, int gw, int NGW, int wave, int lane) {
    const bf16* QK = (const bf16*)(ws + WS_QKV); const float* GIF = (const float*)(ws + WS_GIF);
    const float* DC = (const float*)(ws + WS_DC); const float* BEND = (const float*)(ws + WS_SMALL); const float* MST = BEND + 2 * 2048; const float* DN = BEND + 3 * 2048;
    bf16* Y = (bf16*)(ws + WS_XN); const float* BCUM = (const float*)(ws + WS_USUM); const float* GMX = BCUM + (size_t)M * 8;
    LAS unsigned char* wl = lds + wave * MLC_STRIDE;
    LAS bf16* vt_l = (LAS bf16*)wl;
    LAS float* gt = (LAS float*)(wl + 16384); LAS float* mt = gt + 64; LAS float* wtb = gt + 128; LAS float* et = gt + 192;
    const int r32 = lane & 31, hh = lane >> 5;
    for (int unit = gw; unit < 16 * NCH; unit += NGW) {
        const int bh = unit >> 7, c = unit & 127, b = bh >> 3, h = bh & 7, tok0 = b * T + c * LC;
        {   const int tok = tok0 + lane; const float li = GIF[(size_t)tok * 16 + h], bc = BCUM[(size_t)tok * 8 + h], mxp = GMX[(size_t)tok * 8 + h], mc = MST[unit];
            const float mmax = fmaxf(mc, mxp);
            gt[lane] = li - bc; mt[lane] = mmax; wtb[lane] = expf(mc - mmax); et[lane] = expf(-(bc + mmax)); }
#pragma unroll 4
        for (int it = 0; it < 16; ++it) { const int idx = it * 64 + lane, row = idx >> 4, ch = idx & 15;
            *(LAS v4u*)(wl + row * 256 + ch * 16) = *(const GAS v4u*)(QK + (size_t)(tok0 + row) * NIN_G + 1024 + h * DV + ch * 8); }
        LDS_WAIT(); asm volatile("" ::: "memory");
        float nhv[4];
#pragma unroll
        for (int vt = 0; vt < 4; ++vt) nhv[vt] = norm_h[h * DV + 32 * vt + r32];
        const LAS bf16* vl = vt_l + 4 * hh * 128 + r32;
#pragma unroll
        for (int tti = 0; tti < 2; ++tti) {
            constexpr int dummy = 0; (void)dummy;
            const int tt = 1 - tti;
            const int NST = tt + 1;
            const int myt = 32 * tt + r32; const float mmax_t = mt[myt], winter_t = wtb[myt];
            const bf16* qrow = QK + (size_t)(tok0 + myt) * NIN_G + h * DQK + 8 * hh;
            b8 Qf[4];
#pragma unroll
            for (int ks = 0; ks < 4; ++ks) Qf[ks] = *(const GAS b8*)(qrow + 16 * ks);
            b8 PA[2][2];
#pragma unroll
            for (int st = 0; st < 2; ++st) { if (st < NST) {
                f16v X;
#pragma unroll
                for (int i = 0; i < 16; ++i) X[i] = 0.f;
                const bf16* krow = QK + (size_t)(tok0 + 32 * st + r32) * NIN_G + 512 + h * DQK + 8 * hh;
#pragma unroll
                for (int ks = 0; ks < 4; ++ks) X = MFMA32(*(const GAS b8*)(krow + 16 * ks), Qf[ks], X);
                float xs[16];
#pragma unroll
                for (int i = 0; i < 16; ++i) { const int s = 32 * st + (i & 3) + 8 * (i >> 2) + 4 * hh; xs[i] = (s <= myt) ? X[i] * expf(gt[s] - mmax_t) : 0.f; }
                PA[st][0] = mk_b8(pk_bf16(xs[0], xs[1]), pk_bf16(xs[2], xs[3]), pk_bf16(xs[4], xs[5]), pk_bf16(xs[6], xs[7]));
                PA[st][1] = mk_b8(pk_bf16(xs[8], xs[9]), pk_bf16(xs[10], xs[11]), pk_bf16(xs[12], xs[13]), pk_bf16(xs[14], xs[15]));
            } }
            b8 QW[4];
#pragma unroll
            for (int ks = 0; ks < 4; ++ks) { const v4u w = __builtin_bit_cast(v4u, Qf[ks]);
                QW[ks] = mk_b8(pk_bf16(bf_lo(w.x) * winter_t, bf_hi(w.x) * winter_t), pk_bf16(bf_lo(w.y) * winter_t, bf_hi(w.y) * winter_t),
                               pk_bf16(bf_lo(w.z) * winter_t, bf_hi(w.z) * winter_t), pk_bf16(bf_lo(w.w) * winter_t, bf_hi(w.w) * winter_t)); }
            f16v acc[5];
#pragma unroll
            for (int vt = 0; vt < 5; ++vt) {
#pragma unroll
                for (int i = 0; i < 16; ++i) acc[vt][i] = 0.f;
#pragma unroll
                for (int st = 0; st < 2; ++st) { if (st < NST) {
#pragma unroll
                    for (int sp = 0; sp < 2; ++sp) { b8 Vf;
                        if (vt < 4) { unsigned e[8];
#pragma unroll
                            for (int j = 0; j < 8; ++j) e[j] = (unsigned)vl[(32 * st + 16 * sp + 8 * (j >> 2) + (j & 3)) * 128 + 32 * vt];
                            Vf = mk_b8(e[0] | (e[1] << 16), e[2] | (e[3] << 16), e[4] | (e[5] << 16), e[6] | (e[7] << 16)); }
                        else { const unsigned one = (r32 == 0) ? 0x3f803f80u : 0u; Vf = mk_b8(one, one, one, one); }
                        acc[vt] = MFMA32(PA[st][sp], Vf, acc[vt]); } } }
#pragma unroll
                for (int ks = 0; ks < 4; ++ks) { b8 Cf;
                    const float* cp = (vt < 4) ? DC + ((size_t)unit * 128 + 32 * vt + r32) * 64 + 8 * hh + 16 * ks : DN + (size_t)unit * 64 + 8 * hh + 16 * ks;
                    const f32x4 c0 = *(const GAS f32x4*)cp, c1 = *(const GAS f32x4*)(cp + 4);
                    Cf = mk_b8(pk_bf16(c0.x, c0.y), pk_bf16(c0.z, c0.w), pk_bf16(c1.x, c1.y), pk_bf16(c1.z, c1.w));
                    if (vt == 4 && r32 != 0) Cf = mk_b8(0u, 0u, 0u, 0u);
                    acc[vt] = MFMA32(QW[ks], Cf, acc[vt]); }
            }
            LDS_WAIT(); asm volatile("" ::: "memory");
#pragma unroll
            for (int i = 0; i < 16; ++i) {
                const int trow = 32 * tt + (i & 3) + 8 * (i >> 2) + 4 * hh;
                const float den = bperm_f(lane & 32, acc[4][i]);
                const float inv = 1.0f / fmaxf(fabsf(den), et[trow]);
                float ss = 0.f;
#pragma unroll
                for (int vt = 0; vt < 4; ++vt) { const float hv = acc[vt][i] * inv; ss += hv * hv; }
#pragma unroll
                for (int o = 1; o < 32; o <<= 1) ss += bperm_f(lane ^ o, ss);
                const float sc = inv / sqrtf(ss * (1.0f / DV) + RMS_EPS);
#pragma unroll
                for (int vt = 0; vt < 4; ++vt) vt_l[trow * 128 + 32 * vt + r32] = (bf16)f2bf(acc[vt][i] * sc * nhv[vt]);
            }
        }
        LDS_WAIT(); asm volatile("" ::: "memory");
#pragma unroll 4
        for (int it = 0; it < 16; ++it) { const int idx = it * 64 + lane, row = idx >> 4, ch = idx & 15;
            const v4u yv = *(const LAS v4u*)(wl + row * 256 + ch * 16); const v4u ov = *(const GAS v4u*)(QK + (size_t)(tok0 + row) * NIN_G + 2048 + h * DV + ch * 8);
            float y[8] = {bf_lo(yv.x), bf_hi(yv.x), bf_lo(yv.y), bf_hi(yv.y), bf_lo(yv.z), bf_hi(yv.z), bf_lo(yv.w), bf_hi(yv.w)};
            const float o[8] = {bf_lo(ov.x), bf_hi(ov.x), bf_lo(ov.y), bf_hi(ov.y), bf_lo(ov.z), bf_hi(ov.z), bf_lo(ov.w), bf_hi(ov.w)};
#pragma unroll
            for (int e = 0; e < 8; ++e) y[e] = y[e] * (1.0f / (1.0f + expf(-o[e])));
            v4u w; w.x = pk2(y[0], y[1]); w.y = pk2(y[2], y[3]); w.z = pk2(y[4], y[5]); w.w = pk2(y[6], y[7]);
            *(GAS v4u*)(Y + (size_t)(tok0 + row) * D + h * DV + ch * 8) = w; }
        LDS_WAIT(); asm volatile("" ::: "memory");
    }
}

struct Args { const float* in[13]; float* out; unsigned char* ws; };
__global__ void __launch_bounds__(NTHR, 2) fwd_kernel(Args args) {
    extern __shared__ __attribute__((aligned(16))) unsigned char lds_raw[];
    LAS unsigned char* lds = (LAS unsigned char*)lds_raw;
    volatile LAS unsigned* MISC = (volatile LAS unsigned*)(lds + MISC_OFF);
    const int wave = __builtin_amdgcn_readfirstlane((int)threadIdx.x >> 6);
    const int G = gridDim.x, wg = blockIdx.x;
#define FRESH int lane_ = (int)__lane_id(); asm volatile("" : "+v"(lane_)); const int lane = lane_; const int tid = wave * 64 + lane; (void)tid;
    const int gw = wg * NWAVES + wave, NGW = G * NWAVES;
    unsigned char* ws = args.ws;
    gu32* ctl = (gu32*)(ws + WS_CTL);
    { FRESH for (int u = tid; u < (LDS_BYTES - LDSCTL_OFF) / 4; u += NTHR) ((LAS unsigned*)(lds + LDSCTL_OFF))[u] = 0u; }
    __syncthreads();
    XcdBarrier bar = xcd_barrier_post((unsigned*)(ctl + CW_BAR), MISC + 8);
#define GRID_BAR() do { FRESH xcd_barrier(bar, tid == 0); } while (0)
    const float* x = args.in[0]; const float* g_mix_pre = args.in[1]; const float* g_mix_post = args.in[2]; const float* g_ffn_pre = args.in[3]; const float* g_ffn_post = args.in[4];
    const float* w_up = args.in[5]; const float* w_down = args.in[6]; const float* w_qkv = args.in[7]; const float* w_o = args.in[8];
    const float* w_in = args.in[9]; const float* b_gates = args.in[10]; const float* norm_h = args.in[11]; const float* w_out = args.in[12];
    float* out = args.out;
    bf16* W_IN = (bf16*)(ws + WS_W); bf16* W_OUT = (bf16*)(ws + WS_W + 6 * MiB); bf16* W_UP = (bf16*)(ws + WS_W + 8 * MiB); bf16* W_DN = (bf16*)(ws + WS_W + 16 * MiB);
    bf16* XN = (bf16*)(ws + WS_XN); bf16* QKV = (bf16*)(ws + WS_QKV); float* U = (float*)(ws + WS_U);

    { FRESH convert_weights(w_qkv, 3072, w_o, w_up, w_down, ws, lds, gw, NGW, wave, lane); }
    __syncthreads();
    { FRESH phase_p0(x, g_mix_pre, ws, lds, wg, G, tid, wave, lane); }
    GRID_BAR();
    {
        pg8::Gemm g{XN, W_IN, M, 3 * D, D}; pg8::StaticOrder S; S.init(M, 3 * D, G, wg);
        pg8::EpiBf16<0> E{QKV, D, D, (size_t)M * D, 0, D, QSCALE};
        FRESH pg8::gemm_phase<pg8::EpiBf16<0>, pg8::StaticOrder, true, true>(lds, g, S, E, tid);
    }
    { FRESH phase_kmean(w_qkv, ws, wg, G, wave, lane); }
    GRID_BAR();
    { FRESH phase_g(w_qkv, ws, wg, G, wave, lane); }
    GRID_BAR();
    { FRESH phase_gate(ws, lds, wg, G, wave, lane); }
    GRID_BAR();
    { FRESH phase_lists(ws, gw, NGW, lane); }
    GRID_BAR();
    { FRESH phase_attn(ws, (char*)lds_raw, wg, G, tid); }
    GRID_BAR();
    { FRESH phase_combine(ws, wg * NTHR + tid, G * NTHR); }
    GRID_BAR();
    {
        pg8::Gemm g{XN, W_OUT, M, D, D}; pg8::StaticOrder S; S.init(M, D, G, wg);
        pg8::EpiF32 E{U, D};
        FRESH pg8::gemm_phase<pg8::EpiF32, pg8::StaticOrder, true, true>(lds, g, S, E, tid);
    }
    GRID_BAR();
    { FRESH norm_rows<true, false>(U, x, out, g_mix_post, g_ffn_pre, XN, nullptr, nullptr, nullptr, gw, NGW, lane); }
    GRID_BAR();
    {
        pg8::Gemm g{XN, W_UP, M, FF, D}; pg8::StaticOrder S; S.init(M, FF, G, wg);
        pg8::EpiBf16<2> E{QKV, FF, 0, 0, 0, 0, 1.f};
        FRESH pg8::gemm_phase<pg8::EpiBf16<2>, pg8::StaticOrder, true, true>(lds, g, S, E, tid);
    }
    GRID_BAR();
    {
        pg8::Gemm g{QKV, W_DN, M, D, FF}; pg8::StaticOrder S; S.init(M, D, G, wg);
        pg8::EpiF32 E{U, D};
        FRESH pg8::gemm_phase<pg8::EpiF32, pg8::StaticOrder, true, true>(lds, g, S, E, tid);
    }
    GRID_BAR();
    { FRESH convert_weights(w_in, NIN, w_out, w_up + (size_t)D * FF, w_down + (size_t)D * FF, ws, lds, gw, NGW, wave, lane); }
    __syncthreads();
    {
        LAS float* wgl = (LAS float*)lds;
        { FRESH for (int e = tid; e < 16 * 1024; e += NTHR) { const int k = e >> 4, gg = e & 15; wgl[gg * 1024 + k] = w_in[(size_t)k * NIN + NIN_G + gg]; } }
        __syncthreads();
        { FRESH norm_rows<true, true>(U, out, out, g_ffn_post, g_mix_pre + D, XN, wgl, b_gates, (float*)(ws + WS_GIF), gw, NGW, lane); }
    }
    GRID_BAR();
    {
        pg8::Gemm g{XN, W_IN, M, NIN_G, D}; pg8::StaticOrder S; S.init(M, NIN_G, G, wg);
        pg8::EpiBf16<0> E{QKV, NIN_G, 0, 0, 512, 1024, 0.125f};
        FRESH pg8::gemm_phase<pg8::EpiBf16<0>, pg8::StaticOrder, true, true>(lds, g, S, E, tid);
    }
    GRID_BAR();
    { FRESH phase_mlstm_a(ws, lds, gw, NGW, wave, lane); }
    GRID_BAR();
    { FRESH phase_mlstm_b(ws, wg * NTHR + tid, G * NTHR); }
    GRID_BAR();
    { FRESH phase_mlstm_c(norm_h, ws, lds, gw, NGW, wave, lane); }
    GRID_BAR();
    {
        pg8::Gemm g{XN, W_OUT, M, D, D}; pg8::StaticOrder S; S.init(M, D, G, wg);
        pg8::EpiF32 E{U, D};
        FRESH pg8::gemm_phase<pg8::EpiF32, pg8::StaticOrder, true, true>(lds, g, S, E, tid);
    }
    GRID_BAR();
    { FRESH norm_rows<true, false>(U, out, out, g_mix_post + D, g_ffn_pre + D, XN, nullptr, nullptr, nullptr, gw, NGW, lane); }
    GRID_BAR();
    {
        pg8::Gemm g{XN, W_UP, M, FF, D}; pg8::StaticOrder S; S.init(M, FF, G, wg);
        pg8::EpiBf16<2> E{QKV, FF, 0, 0, 0, 0, 1.f};
        FRESH pg8::gemm_phase<pg8::EpiBf16<2>, pg8::StaticOrder, true, true>(lds, g, S, E, tid);
    }
    GRID_BAR();
    {
        pg8::Gemm g{QKV, W_DN, M, D, FF}; pg8::StaticOrder S; S.init(M, D, G, wg);
        pg8::EpiF32 E{U, D};
        FRESH pg8::gemm_phase<pg8::EpiF32, pg8::StaticOrder, true, true>(lds, g, S, E, tid);
    }
    GRID_BAR();
    { FRESH norm_rows<false, false>(U, out, out, g_ffn_post + D, nullptr, nullptr, nullptr, nullptr, nullptr, gw, NGW, lane); }
}

extern "C" void kernel_launch(void* const* d_in, const int* in_sizes, int n_in, void* d_out, int out_size, void* d_ws, size_t ws_size, hipStream_t stream) {
    static int grid = 0;
    if (grid == 0) {
        if (n_in != 13 || in_sizes[0] != M * D || out_size != M * D || ws_size < WS_END) { fprintf(stderr, "kernel_launch: unexpected shapes (n_in %d in0 %d out %d ws %zu)\n", n_in, n_in > 0 ? in_sizes[0] : -1, out_size, ws_size); grid = -1; return; }
        int dev = 0, cus = 0;
        if (hipGetDevice(&dev) != hipSuccess || hipDeviceGetAttribute(&cus, hipDeviceAttributeMultiprocessorCount, dev) != hipSuccess) { grid = -1; return; }
        if (hipFuncSetAttribute((const void*)fwd_kernel, hipFuncAttributeMaxDynamicSharedMemorySize, LDS_BYTES) != hipSuccess) { fprintf(stderr, "kernel_launch: hipFuncSetAttribute failed\n"); grid = -1; return; }
        int per_cu = 0;
        if (hipOccupancyMaxActiveBlocksPerMultiprocessor(&per_cu, (const void*)fwd_kernel, NTHR, LDS_BYTES) != hipSuccess || per_cu < 1) fprintf(stderr, "kernel_launch: occupancy query reports %d\n", per_cu);
        (void)hipGetLastError();
        grid = cus;
    }
    if (grid < 0) return;
    if (hipMemsetAsync((char*)d_ws + WS_CTL, 0, CTL_ZERO_BYTES, stream) != hipSuccess) return;
    Args a{};
    for (int i = 0; i < 13; ++i) a.in[i] = (const float*)d_in[i];
    a.out = (float*)d_out; a.ws = (unsigned char*)d_ws;
    hipLaunchKernelGGL(fwd_kernel, dim3(grid), dim3(NTHR), LDS_BYTES, stream, a);
}
```
